# Optimizing an MI355X kernel written in HIP

```python
import jax, jax.numpy as jnp
from jax import lax
import numpy as np

D_MODEL = 2048
BATCH = 8
SEQ = 4096
DEPTH = 1
DEC_BATCH = 16
DEC_SEQ = 16
PAST_LEN = 4096

CHUNK = 64
WINDOW = 128
WIN_CHUNKS = WINDOW // CHUNK
ATT_WIDTH = D_MODEL // 2
GLA_WIDTH = D_MODEL - ATT_WIDTH
HEAD_DIM = 64
N_HEADS = ATT_WIDTH // HEAD_DIM
N_KV = 4
GQA_REP = N_HEADS // N_KV
N_GLA = 4
GLA_DV = GLA_WIDTH // N_GLA
GLA_DK = GLA_DV // 2
GLA_KW = N_GLA * GLA_DK
GATE_RANK = 16
GATE_TAU = 16.0
EPS = 1e-6
ATT_SCALE = HEAD_DIM ** -0.5
ATT_CACHE = min(WINDOW, PAST_LEN)
IN_SIZES = (ATT_WIDTH, N_KV * HEAD_DIM, N_KV * HEAD_DIM, ATT_WIDTH,
            GLA_KW, GLA_KW, GLA_WIDTH, GLA_WIDTH, GATE_RANK)
IN_TOTAL = sum(IN_SIZES)
SPLITS = tuple(int(s) for s in np.cumsum(IN_SIZES)[:-1])

kernel_name = "hymba_swa_sink_gla_streaming_step"


def rmsnorm(x, g):
    xf = x.astype(jnp.float32)
    y = xf * lax.rsqrt(jnp.mean(xf * xf, axis=-1, keepdims=True) + EPS)
    return (y * g.astype(jnp.float32)).astype(x.dtype)


def sink_softmax(s, sink):
    m = jnp.maximum(jnp.max(s, axis=-1, keepdims=True), sink)
    e = jnp.exp(s - m)
    return e / (jnp.sum(e, axis=-1, keepdims=True) + jnp.exp(sink - m))


def branch_inputs(x, norm_g, w_in, w_gate_up, b_gate, q_norm_g, k_norm_g):
    B, T, _ = x.shape
    xn = rmsnorm(x, norm_g)
    h = xn @ w_in
    qa, ka, va, ga, qg, kg, vg, gg, lr = jnp.split(h, SPLITS, axis=-1)
    qa = rmsnorm(qa.reshape(B, T, N_HEADS, HEAD_DIM), q_norm_g)
    ka = rmsnorm(ka.reshape(B, T, N_KV, HEAD_DIM), k_norm_g)
    va = va.reshape(B, T, N_KV, HEAD_DIM)
    qg = qg.reshape(B, T, N_GLA, GLA_DK) * (GLA_DK ** -0.5)
    kg = kg.reshape(B, T, N_GLA, GLA_DK)
    vg = vg.reshape(B, T, N_GLA, GLA_DV)
    log_a = jax.nn.log_sigmoid((lr @ w_gate_up + b_gate).astype(jnp.float32)) / GATE_TAU
    log_a = log_a.reshape(B, T, N_GLA, GLA_DK)
    return qa, ka, va, ga, qg, kg, vg, gg, log_a


def swa_prompt(q, k, v, sinks):
    B, S = q.shape[:2]
    n = S // CHUNK
    L = (WIN_CHUNKS + 1) * CHUNK
    qb = q.reshape(B, n, CHUNK, N_KV, GQA_REP, HEAD_DIM).astype(jnp.float32)
    pad = ((0, 0), (WINDOW, 0), (0, 0), (0, 0))
    kp = jnp.pad(k, pad).reshape(B, n + WIN_CHUNKS, CHUNK, N_KV, HEAD_DIM)
    vp = jnp.pad(v, pad).reshape(B, n + WIN_CHUNKS, CHUNK, N_KV, HEAD_DIM)
    kband = jnp.concatenate([kp[:, i:i + n] for i in range(WIN_CHUNKS + 1)], axis=2)
    vband = jnp.concatenate([vp[:, i:i + n] for i in range(WIN_CHUNKS + 1)], axis=2)
    key_pos = jnp.arange(n)[:, None] * CHUNK - WINDOW + jnp.arange(L)[None, :]
    valid = key_pos >= 0
    s = jnp.einsum('bnqgrd,bnkgd->bngrqk', qb, kband.astype(jnp.float32)) * ATT_SCALE
    s = jnp.where(valid[None, :, None, None, None, :], s, -jnp.inf)
    sink = sinks.astype(jnp.float32).reshape(N_KV, GQA_REP)[None, None, :, :, None, None]
    p = sink_softmax(s, sink)
    o = jnp.einsum('bngrqk,bnkgd->bnqgrd', p.astype(v.dtype), vband)
    return o.reshape(B, S, ATT_WIDTH)


def swa_sample(q, k_new, v_new, cache_k, cache_v, sinks):
    B, T = q.shape[:2]
    keys = jnp.concatenate([cache_k.astype(k_new.dtype), k_new], axis=1)
    vals = jnp.concatenate([cache_v.astype(v_new.dtype), v_new], axis=1)
    qg = q.reshape(B, T, N_KV, GQA_REP, HEAD_DIM).astype(jnp.float32)
    s = jnp.einsum('btgrd,bsgd->bgrts', qg, keys.astype(jnp.float32)) * ATT_SCALE
    sink = sinks.astype(jnp.float32).reshape(N_KV, GQA_REP)[None, :, :, None, None]
    p = sink_softmax(s, sink)
    o = jnp.einsum('bgrts,bsgd->btgrd', p.astype(vals.dtype), vals).reshape(B, T, ATT_WIDTH)
    return o, keys[:, -ATT_CACHE:], vals[:, -ATT_CACHE:]


def gla_scan(q, k, v, log_a, s0):
    B, T, H, _ = q.shape
    blk = min(CHUNK, T)
    n = T // blk

    def blocks(a):
        return jnp.moveaxis(a.astype(jnp.float32).reshape(B, n, blk, H, a.shape[-1]), 1, 0)

    causal = jnp.tril(jnp.ones((blk, blk), dtype=bool))

    def step(S, inp):
        qc, kc, vc, ac = inp
        bcum = jnp.cumsum(ac, axis=1)
        diff = bcum[:, :, None] - bcum[:, None, :]
        decay = jnp.exp(jnp.where(causal[None, :, :, None, None], diff, -jnp.inf))
        att = jnp.einsum('bijhd,bjhd->bhij', qc[:, :, None] * decay, kc)
        o = (jnp.einsum('bhij,bjhe->bihe', att, vc)
             + jnp.einsum('bihd,bhde->bihe', qc * jnp.exp(bcum), S))
        blast = bcum[:, -1]
        S = (jnp.exp(blast)[..., None] * S
             + jnp.einsum('bjhd,bjhe->bhde', kc * jnp.exp(blast[:, None] - bcum), vc))
        return S, o

    S, o = lax.scan(step, s0.astype(jnp.float32), (blocks(q), blocks(k), blocks(v), blocks(log_a)))
    o = jnp.moveaxis(o, 0, 1).reshape(B, T, H, v.shape[-1])
    return o, S


def merge(x, o_attn, ga, o_gla, gg, gla_norm_g, w_out):
    B, T, _ = x.shape
    o_gla = rmsnorm(o_gla.astype(x.dtype), gla_norm_g).reshape(B, T, GLA_WIDTH)
    mix = jnp.concatenate([o_attn * jax.nn.silu(ga), o_gla * jax.nn.silu(gg)], axis=-1)
    return x + mix @ w_out


def setup_inputs(seed: int = 0) -> dict:
    key = jax.random.key(seed)
    ks = jax.random.split(key, 16)
    f32 = jnp.float32
    nrm = jax.random.normal
    return {
        "x_prompt": nrm(ks[0], (BATCH, SEQ, D_MODEL), f32),
        "x_sample": nrm(ks[1], (DEC_BATCH, DEC_SEQ, D_MODEL), f32),
        "cache_k": nrm(ks[2], (DEPTH, DEC_BATCH, ATT_CACHE, N_KV, HEAD_DIM), f32),
        "cache_v": nrm(ks[3], (DEPTH, DEC_BATCH, ATT_CACHE, N_KV, HEAD_DIM), f32),
        "state_gla": nrm(ks[4], (DEPTH, DEC_BATCH, N_GLA, GLA_DK, GLA_DV), f32) * 0.5,
        "norm_g": 1.0 + 0.02 * nrm(ks[5], (DEPTH, D_MODEL), f32),
        "w_in": nrm(ks[6], (DEPTH, D_MODEL, IN_TOTAL), f32) * D_MODEL ** -0.5,
        "w_gate_up": nrm(ks[7], (DEPTH, GATE_RANK, GLA_KW), f32) * GATE_RANK ** -0.5,
        "b_gate": 0.1 * nrm(ks[8], (DEPTH, GLA_KW), f32),
        "q_norm_g": 1.0 + 0.02 * nrm(ks[9], (DEPTH, HEAD_DIM), f32),
        "k_norm_g": 1.0 + 0.02 * nrm(ks[10], (DEPTH, HEAD_DIM), f32),
        "sinks": 0.5 * nrm(ks[11], (DEPTH, N_HEADS), f32),
        "gla_norm_g": 1.0 + 0.02 * nrm(ks[12], (DEPTH, GLA_DV), f32),
        "w_out": nrm(ks[13], (DEPTH, ATT_WIDTH + GLA_WIDTH, D_MODEL), f32) * (ATT_WIDTH + GLA_WIDTH) ** -0.5,
    }


def reference(x_prompt, x_sample, cache_k, cache_v, state_gla, norm_g, w_in, w_gate_up, b_gate,
              q_norm_g, k_norm_g, sinks, gla_norm_g, w_out):
    h_p, h_s = x_prompt, x_sample
    pk, pv, ps, sk, sv, ss = [], [], [], [], [], []
    for l in range(DEPTH):
        qa, ka, va, ga, qg, kg, vg, gg, la = branch_inputs(
            h_p, norm_g[l], w_in[l], w_gate_up[l], b_gate[l], q_norm_g[l], k_norm_g[l])
        oa = swa_prompt(qa, ka, va, sinks[l])
        s0 = jnp.zeros((h_p.shape[0], N_GLA, GLA_DK, GLA_DV), jnp.float32)
        og, sg = gla_scan(qg, kg, vg, la, s0)
        h_p = merge(h_p, oa, ga, og, gg, gla_norm_g[l], w_out[l])
        pk.append(ka[:, -ATT_CACHE:])
        pv.append(va[:, -ATT_CACHE:])
        ps.append(sg.astype(state_gla.dtype))
        qa, ka, va, ga, qg, kg, vg, gg, la = branch_inputs(
            h_s, norm_g[l], w_in[l], w_gate_up[l], b_gate[l], q_norm_g[l], k_norm_g[l])
        oa, nk, nv = swa_sample(qa, ka, va, cache_k[l], cache_v[l], sinks[l])
        og, sg = gla_scan(qg, kg, vg, la, state_gla[l])
        h_s = merge(h_s, oa, ga, og, gg, gla_norm_g[l], w_out[l])
        sk.append(nk)
        sv.append(nv)
        ss.append(sg.astype(state_gla.dtype))
    return (h_p, h_s, jnp.stack(pk), jnp.stack(pv), jnp.stack(ps), jnp.stack(sk), jnp.stack(sv), jnp.stack(ss))
```

```cpp
#include <hip/hip_runtime.h>
#include <hip/hip_cooperative_groups.h>
#include <cstdio>
#include <cstdint>
namespace cg = cooperative_groups;
namespace pg8 {
#define PG8_LAS __attribute__((address_space(3)))
typedef unsigned short bf16_t;
typedef short bf16x8 __attribute__((ext_vector_type(8)));
typedef float f32x4 __attribute__((ext_vector_type(4)));
typedef unsigned u32x4 __attribute__((ext_vector_type(4)));
constexpr int BM = 256, BK = 64, HALF = 128, HTB = HALF * BK * 2  , STAGE_BYTES = 8 * HTB, NXCD = 8, WGM = 8;

__host__ __device__ __forceinline__ int lds_byte(int r, int c) { const int st = (r >> 4) * 2 + (c >> 5), rr = r & 15, cc = c & 31, ob = rr * 64 + cc * 2; return st * 1024 + (ob ^ (((ob >> 9) & 1) << 5)); }
__host__ __device__ __forceinline__ void stage_rc(int b, int& R, int& C) { const int st = b / 1024, sb = b % 1024, swz = sb ^ (((sb >> 9) & 1) << 5); R = (st >> 1) * 16 + swz / 64; C = (st & 1) * 32 + (swz % 64) / 2; }
__host__ __device__ __forceinline__ int perm32(int rho) { const int n = rho >> 4, i = rho & 15; return 8 * (i >> 2) + 4 * n + (i & 3); }

struct Unit { int pm, pn; };
struct Gemm { const bf16_t* A; const bf16_t* Bt; int M, N, K; };

struct StaticOrder {
    int nM, nN, nwg, G, c;
    __host__ __device__ void init(int M, int N, int G_, int c_) { nM = M / BM; nN = N / BM; nwg = nM * nN; G = G_; c = c_; }
    __host__ __device__ bool next(int i, Unit& u) const {
        const long L = (long)i * G + c; if (L >= nwg) return false;
        int wgid = (int)L; { const int q = nwg / NXCD, r = nwg % NXCD, xcd = wgid % NXCD, off = wgid / NXCD; wgid = (xcd < r ? xcd * (q + 1) : r * (q + 1) + (xcd - r) * q) + off; }
        const int nig = WGM * nN, gid = wgid / nig, fm = gid * WGM, gsz = (nM - fm) < WGM ? (nM - fm) : WGM;
        u.pm = fm + ((wgid % nig) % gsz); u.pn = (wgid % nig) / gsz; return true;
    }
    __device__ __forceinline__ void a_ready(const Unit&) const {}
    __device__ __forceinline__ void done(const Unit&) const {}
};

__device__ __forceinline__ unsigned cvt_pk_bf16(float lo, float hi) { unsigned r; asm volatile("v_cvt_pk_bf16_f32 %0, %1, %2" : "=v"(r) : "v"(lo), "v"(hi)); return r; }
struct EpiH {
    static constexpr bool PERM = true, AFTER_DRAIN = false;
    bf16_t* O; int ldc;
    __device__ __forceinline__ void operator()(const f32x4 (&acc)[2][2][4][2], const Unit& u, int wr, int wc, int fr, int fq) const {
        const int row0 = u.pm * BM + wr * 64 + fr, col0 = u.pn * BM + wc * 32 + 8 * fq;
#pragma unroll
        for (int ai = 0; ai < 2; ++ai)
#pragma unroll
            for (int m = 0; m < 4; ++m) { bf16_t* rowp = O + (size_t)(row0 + ai * HALF + m * 16) * ldc + col0;
#pragma unroll
                for (int bj = 0; bj < 2; ++bj) { const f32x4 v0 = acc[ai][bj][m][0], v1 = acc[ai][bj][m][1];
                    u32x4 w; w.x = cvt_pk_bf16(v0[0], v0[1]); w.y = cvt_pk_bf16(v0[2], v0[3]); w.z = cvt_pk_bf16(v1[0], v1[1]); w.w = cvt_pk_bf16(v1[2], v1[3]);
                    *(u32x4*)(rowp + bj * HALF) = w; } }
    }
};
struct EpiRes {
    static constexpr bool PERM = false, AFTER_DRAIN = false;
    const float* xa; const float* xb; float* C; int split_pm;
    __device__ __forceinline__ void operator()(const f32x4 (&acc)[2][2][4][2], const Unit& u, int wr, int wc, int fr, int fq) const {
        const int lrow0 = wr * 64 + fr, col0 = u.pn * BM + wc * 32 + 4 * fq;
        const float* xt = (u.pm < split_pm) ? xa + (size_t)u.pm * BM * 2048 : xb + (size_t)(u.pm - split_pm) * BM * 2048;
        float* ct = C + (size_t)u.pm * BM * 2048;
#pragma unroll
        for (int ai = 0; ai < 2; ++ai)
#pragma unroll
            for (int m = 0; m < 4; ++m) { const size_t off = (size_t)(lrow0 + ai * HALF + m * 16) * 2048 + col0;
#pragma unroll
                for (int bj = 0; bj < 2; ++bj)
#pragma unroll
                    for (int n = 0; n < 2; ++n) *(f32x4*)(ct + off + bj * HALF + n * 16) = acc[ai][bj][m][n] + *(const f32x4*)(xt + off + bj * HALF + n * 16); }
    }
};
template <class Epi, class Sched, bool ALIGN_EPI = false, bool SP2 = false>
__device__ __forceinline__ void gemm_phase(PG8_LAS unsigned char* lds, const Gemm g, const Sched& S, const Epi& E) {
    const int tid = threadIdx.x, wid = __builtin_amdgcn_readfirstlane(tid >> 6), lane = tid & 63, wr = wid >> 2, wc = wid & 3, fr = lane & 15, fq = lane >> 4;
    const int K = g.K, nt = K / BK;
    unsigned voffA[2], voffB[2];
#pragma unroll
    for (int i = 0; i < 2; ++i) { int R, C; stage_rc(tid * 16 + i * 8192, R, C); const int Rb = Epi::PERM ? ((R & ~31) + perm32(R & 31)) : R;
        voffA[i] = (unsigned)(R * K + C) * 2u; voffB[i] = (unsigned)(Rb * K + C) * 2u; }
    const size_t kstep = (size_t)(BK * 2);
    const size_t hstep = (size_t)HALF * K * 2;
    const size_t tstep = 2 * hstep;
    const unsigned ldsw = (unsigned)wid * 1024u;
    const int aoff = lds_byte(wr * 64 + fr, fq * 8), boff = lds_byte(wc * 32 + fr, fq * 8);
#define PG8_SA(b, h) (((b) * 2 + (h)) * HTB)
#define PG8_SB(b, h) ((4 + (b) * 2 + (h)) * HTB)
#define PG8_STAGE(bufoff, gbase, voff) do { _Pragma("unroll") for (int _i = 0; _i < 2; ++_i) \
        __builtin_amdgcn_global_load_lds((const unsigned*)((const char*)(gbase) + (voff)[_i]), (PG8_LAS unsigned*)(lds + (bufoff) + ldsw + _i * 8192), 16, 0, 0); } while (0)
#define PG8_LDA(dst, b, h) do { _Pragma("unroll") for (int m = 0; m < 4; ++m) _Pragma("unroll") for (int k = 0; k < 2; ++k) dst[m][k] = *(const PG8_LAS bf16x8*)(lds + PG8_SA(b, h) + aoff + m * 2048 + k * 1024); } while (0)
#define PG8_LDB(dst, b, h) do { _Pragma("unroll") for (int n = 0; n < 2; ++n) _Pragma("unroll") for (int k = 0; k < 2; ++k) dst[n][k] = *(const PG8_LAS bf16x8*)(lds + PG8_SB(b, h) + boff + n * 2048 + k * 1024); } while (0)
#define PG8_MMA(ai, bj, At, Bt) do { __builtin_amdgcn_s_setprio(1); _Pragma("unroll") for (int m = 0; m < 4; ++m) _Pragma("unroll") for (int n = 0; n < 2; ++n) _Pragma("unroll") for (int k = 0; k < 2; ++k) \
        acc[ai][bj][m][n] = __builtin_amdgcn_mfma_f32_16x16x32_bf16(Bt[n][k], At[m][k], acc[ai][bj][m][n], 0, 0, 0); __builtin_amdgcn_s_setprio(0); } while (0)
#define PG8_WAIT_V(n) asm volatile("s_waitcnt vmcnt(" #n ")" ::: "memory")
#define PG8_WAIT_L(n) asm volatile("s_waitcnt lgkmcnt(" #n ")" ::: "memory")
#define PG8_BAR __builtin_amdgcn_s_barrier()
#define PG8_SCHED __builtin_amdgcn_sched_barrier(0)
    Unit cur, nxt; int ui = 0;
    if (!S.next(0, cur)) return;
    f32x4 acc[2][2][4][2];
#pragma unroll
    for (int a = 0; a < 2; ++a)
#pragma unroll
        for (int b = 0; b < 2; ++b)
#pragma unroll
            for (int m = 0; m < 4; ++m)
#pragma unroll
                for (int n = 0; n < 2; ++n) acc[a][b][m][n] = (f32x4){0.f, 0.f, 0.f, 0.f};
    bf16x8 At[4][2], B0[2][2], B1[2][2];
    const char* cA = (const char*)g.A + (size_t)cur.pm * tstep; const char* cB = (const char*)g.Bt + (size_t)cur.pn * tstep;
    S.a_ready(cur);
    if constexpr (SP2) {
        PG8_STAGE(PG8_SB(0, 0), cB, voffB); PG8_STAGE(PG8_SB(0, 1), cB + hstep, voffB); PG8_STAGE(PG8_SA(0, 0), cA, voffA); PG8_STAGE(PG8_SA(0, 1), cA + hstep, voffA);
        if (wr == 1) PG8_BAR;
        PG8_WAIT_V(2); PG8_BAR;
        PG8_STAGE(PG8_SB(1, 0), cB + kstep, voffB); PG8_STAGE(PG8_SA(1, 0), cA + kstep, voffA); PG8_STAGE(PG8_SB(1, 1), cB + hstep + kstep, voffB);
        PG8_WAIT_V(6); PG8_BAR;
    } else {
        PG8_STAGE(PG8_SB(0, 0), cB, voffB); PG8_STAGE(PG8_SA(0, 0), cA, voffA); PG8_STAGE(PG8_SB(0, 1), cB + hstep, voffB); PG8_STAGE(PG8_SA(0, 1), cA + hstep, voffA);
        if (wr == 1) PG8_BAR;
        PG8_WAIT_V(4); PG8_BAR;
        PG8_STAGE(PG8_SB(1, 0), cB + kstep, voffB); PG8_STAGE(PG8_SA(1, 0), cA + kstep, voffA); PG8_STAGE(PG8_SB(1, 1), cB + hstep + kstep, voffB);
        PG8_WAIT_V(6); PG8_BAR;
    }
    for (;;) {
        const bool has_next = S.next(ui + 1, nxt);
        const char* nA = has_next ? (const char*)g.A + (size_t)nxt.pm * tstep : cA; const char* nB = has_next ? (const char*)g.Bt + (size_t)nxt.pn * tstep : cB;
        for (int t = 0; t < nt; t += 2) {
            const bool last = (t == nt - 2);
            const char* a1 = cA + (size_t)(t + 1) * kstep;
            const char* a2 = last ? nA : cA + (size_t)(t + 2) * kstep; const char* b2 = last ? nB : cB + (size_t)(t + 2) * kstep;
            const char* a3 = a2 + kstep; const char* b3 = b2 + kstep;
            if (last && has_next) S.a_ready(nxt);
            if constexpr (SP2) {
            PG8_LDB(B0, 0, 0); PG8_LDB(B1, 0, 1); PG8_SCHED; PG8_LDA(At, 0, 0); PG8_STAGE(PG8_SA(1, 1), a1 + hstep, voffA);
            PG8_WAIT_V(8); PG8_WAIT_L(0); PG8_BAR; PG8_MMA(0, 0, At, B0); PG8_MMA(0, 1, At, B1); PG8_BAR; PG8_SCHED;
            PG8_LDA(At, 0, 1); PG8_STAGE(PG8_SB(0, 0), b2, voffB); PG8_STAGE(PG8_SB(0, 1), b2 + hstep, voffB); PG8_STAGE(PG8_SA(0, 0), a2, voffA);
            PG8_WAIT_V(8); PG8_WAIT_L(0); PG8_BAR; PG8_MMA(1, 0, At, B0); PG8_MMA(1, 1, At, B1); PG8_BAR; PG8_SCHED;
            PG8_LDB(B0, 1, 0); PG8_LDB(B1, 1, 1); PG8_SCHED; PG8_LDA(At, 1, 0); PG8_STAGE(PG8_SA(0, 1), a2 + hstep, voffA);
            PG8_WAIT_V(8); PG8_WAIT_L(0); PG8_BAR; PG8_MMA(0, 0, At, B0); PG8_MMA(0, 1, At, B1); PG8_BAR; PG8_SCHED;
            PG8_LDA(At, 1, 1); PG8_STAGE(PG8_SB(1, 0), b3, voffB); PG8_STAGE(PG8_SB(1, 1), b3 + hstep, voffB); PG8_STAGE(PG8_SA(1, 0), a3, voffA);
            PG8_WAIT_V(8); PG8_WAIT_L(0); PG8_BAR; PG8_MMA(1, 0, At, B0); PG8_MMA(1, 1, At, B1); PG8_BAR; PG8_SCHED;
            } else {
            PG8_LDB(B0, 0, 0); PG8_SCHED; PG8_LDA(At, 0, 0); PG8_STAGE(PG8_SA(1, 1), a1 + hstep, voffA);
            PG8_WAIT_L(8); PG8_BAR; PG8_WAIT_L(0); PG8_MMA(0, 0, At, B0); PG8_BAR; PG8_SCHED;
            PG8_LDB(B1, 0, 1); PG8_STAGE(PG8_SB(0, 0), b2, voffB);
            PG8_BAR; PG8_WAIT_L(0); PG8_MMA(0, 1, At, B1); PG8_BAR;
            PG8_LDA(At, 0, 1); PG8_STAGE(PG8_SA(0, 0), a2, voffA);
            PG8_BAR; PG8_WAIT_L(0); PG8_MMA(1, 0, At, B0); PG8_BAR; PG8_SCHED;
            PG8_STAGE(PG8_SB(0, 1), b2 + hstep, voffB);
            PG8_WAIT_V(6); PG8_BAR; PG8_MMA(1, 1, At, B1); PG8_BAR;
            PG8_LDB(B0, 1, 0); PG8_SCHED; PG8_LDA(At, 1, 0); PG8_STAGE(PG8_SA(0, 1), a2 + hstep, voffA);
            PG8_WAIT_L(8); PG8_BAR; PG8_WAIT_L(0); PG8_MMA(0, 0, At, B0); PG8_BAR; PG8_SCHED;
            PG8_LDB(B1, 1, 1); PG8_STAGE(PG8_SB(1, 0), b3, voffB);
            PG8_BAR; PG8_WAIT_L(0); PG8_MMA(0, 1, At, B1); PG8_BAR;
            PG8_LDA(At, 1, 1); PG8_STAGE(PG8_SA(1, 0), a3, voffA);
            PG8_BAR; PG8_WAIT_L(0); PG8_MMA(1, 0, At, B0); PG8_BAR; PG8_SCHED;
            PG8_STAGE(PG8_SB(1, 1), b3 + hstep, voffB);
            PG8_WAIT_V(6); PG8_BAR; PG8_MMA(1, 1, At, B1); PG8_BAR;
            }
        }
        if constexpr (ALIGN_EPI) { if (wr == 0) PG8_BAR; }
        if constexpr (!Epi::AFTER_DRAIN) { E(acc, cur, wr, wc, fr, fq); S.done(cur); }
        if (!has_next) break;
#pragma unroll
        for (int a = 0; a < 2; ++a)
#pragma unroll
            for (int b = 0; b < 2; ++b)
#pragma unroll
                for (int m = 0; m < 4; ++m)
#pragma unroll
                    for (int n = 0; n < 2; ++n) acc[a][b][m][n] = (f32x4){0.f, 0.f, 0.f, 0.f};
        cur = nxt; cA = nA; cB = nB; ++ui;
        if constexpr (ALIGN_EPI) { if (wr == 1) PG8_BAR; }
    }
    PG8_WAIT_V(0);
    if constexpr (!ALIGN_EPI) { if (wr == 0) PG8_BAR; }
    PG8_BAR;
    if constexpr (Epi::AFTER_DRAIN) { E.fused(acc, cur, wr, wc, fr, fq, lds, wid, lane); S.done(cur); }
#undef PG8_SA
#undef PG8_SB
#undef PG8_STAGE
#undef PG8_LDA
#undef PG8_LDB
#undef PG8_MMA
#undef PG8_WAIT_V
#undef PG8_WAIT_L
#undef PG8_BAR
#undef PG8_SCHED
}
}
#define LAS __attribute__((address_space(3)))
#define DI __device__ __forceinline__
typedef unsigned short bf16;
typedef short bf16x8 __attribute__((ext_vector_type(8)));
typedef float f32x4 __attribute__((ext_vector_type(4)));
typedef float f32x16 __attribute__((ext_vector_type(16)));
typedef unsigned u32x4 __attribute__((ext_vector_type(4)));
typedef unsigned u32x2 __attribute__((ext_vector_type(2)));
typedef float f32x2_t __attribute__((ext_vector_type(2)));
typedef __bf16 bf16x2_t __attribute__((ext_vector_type(2)));

constexpr int DM = 2048, NB = 8, SEQL = 4096, DECB = 16, DECS = 16;
constexpr int MP = NB * SEQL, MS = DECB * DECS, MT = MP + MS;
constexpr int NIN = 5648, LDH = 5888;
constexpr int C_QA = 0, C_KA = 1024, C_VA = 1280, C_GA = 1536, C_QG = 2560, C_KG = 3072, C_VG = 3584, C_GG = 4608, C_LR = 5632;
constexpr float EPS = 1e-6f;
constexpr size_t MiB = 1u << 20;
constexpr size_t WS_WG = 0, WS_WO = 24 * MiB, WS_XB = 32 * MiB, WS_MIX = 161 * MiB, WS_H = 290 * MiB, WS_END = 662 * MiB;
static_assert(WS_H + (size_t)MT * LDH * 2 <= WS_END && (size_t)LDH * DM * 2 <= WS_WO && WS_XB + (size_t)MT * DM * 2 <= WS_MIX && WS_MIX + (size_t)MT * DM * 2 <= WS_H, "ws map");
constexpr size_t O_YP = 0, O_YS = (size_t)MP * DM, O_WKP = O_YS + (size_t)MS * DM, O_WVP = O_WKP + 262144, O_GP = O_WVP + 262144,
                 O_WKS = O_GP + 1048576, O_WVS = O_WKS + 524288, O_GS = O_WVS + 524288, O_END = O_GS + 2097152;
constexpr int LDS_BYTES = 147456;
constexpr int NTHREADS = 512;

struct Params {
    const float *x_p, *x_s, *cache_k, *cache_v, *state, *norm_g, *w_in, *w_gu, *b_gate, *qng, *kng, *sinks, *gng, *w_out;
    float* out; unsigned char* ws;
};

DI unsigned pk2(float lo, float hi) { f32x2_t v = {lo, hi}; bf16x2_t b = __builtin_convertvector(v, bf16x2_t); return __builtin_bit_cast(unsigned, b); }
DI float bflo(unsigned u) { return __uint_as_float(u << 16); }
DI float bfhi(unsigned u) { return __uint_as_float(u & 0xffff0000u); }
DI float wave_sum(float v) {
#pragma unroll
    for (int o = 1; o < 64; o <<= 1) v += __shfl_xor(v, o);
    return v;
}
DI float silu(float x) { return x / (1.f + __expf(-x)); }
#define MFMA32(a, b, c) __builtin_amdgcn_mfma_f32_32x32x16_bf16((a), (b), (c), 0, 0, 0)
DI f32x16 zero16() { f32x16 z;
#pragma unroll
    for (int i = 0; i < 16; ++i) z[i] = 0.f;
    return z; }
template <int S> DI bf16x8 pack_step(const f32x16& x) {
    u32x4 p; p.x = pk2(x[8 * S + 0], x[8 * S + 1]); p.y = pk2(x[8 * S + 2], x[8 * S + 3]); p.z = pk2(x[8 * S + 4], x[8 * S + 5]); p.w = pk2(x[8 * S + 6], x[8 * S + 7]);
    return __builtin_bit_cast(bf16x8, p);
}
DI bf16x8 lds_b128(LAS const unsigned char* p) { return *(LAS const bf16x8*)p; }
DI bf16x8 lds_2xb64(LAS const unsigned char* p0, LAS const unsigned char* p1) {
    const u32x2 a = *(LAS const u32x2*)p0, b = *(LAS const u32x2*)p1; u32x4 r; r.x = a.x; r.y = a.y; r.z = b.x; r.w = b.y; return __builtin_bit_cast(bf16x8, r);
}

DI void p0_transpose_item(const float* W, const float* rs, int K, int N, bf16* WT, LAS float* scr, int item, int lane) {
    const int nblk = (N + 31) / 32, kb = item / nblk, nb = item % nblk, k0 = 64 * kb, n0 = 32 * nb;
#pragma unroll 8
    for (int i = 0; i < 32; ++i) { const int kk = 2 * i + (lane >> 5), n = n0 + (lane & 31);
        float v = (n < N) ? W[(size_t)(k0 + kk) * N + n] : 0.f; if (rs) v *= rs[k0 + kk];
        scr[kk * 33 + (lane & 31)] = v; }
    asm volatile("s_waitcnt lgkmcnt(0)" ::: "memory");
    const int c = lane & 7;
#pragma unroll
    for (int j = 0; j < 4; ++j) { const int n = (lane >> 3) + 8 * j; LAS const float* s = scr + (8 * c) * 33 + n;
        u32x4 o; o.x = pk2(s[0 * 33], s[1 * 33]); o.y = pk2(s[2 * 33], s[3 * 33]); o.z = pk2(s[4 * 33], s[5 * 33]); o.w = pk2(s[6 * 33], s[7 * 33]);
        *(u32x4*)(WT + (size_t)(n0 + n) * K + k0 + 8 * c) = o; }
    asm volatile("s_waitcnt lgkmcnt(0)" ::: "memory");
}
DI void p0_prologue(const Params& P, LAS unsigned char* lds, int tid) {
    const int lane = tid & 63, wave = tid >> 6, G = gridDim.x;
    const int gw = blockIdx.x * 8 + wave, NGW = G * 8;
    LAS float* scr = (LAS float*)(lds + wave * 16384);
    bf16* WG = (bf16*)(P.ws + WS_WG); bf16* WO = (bf16*)(P.ws + WS_WO); bf16* XB = (bf16*)(P.ws + WS_XB);
    constexpr int I_IN = (DM / 64) * ((NIN + 31) / 32), I_OUT = (DM / 64) * (DM / 32);
    for (int it = gw; it < I_IN + I_OUT; it += NGW) {
        if (it < I_IN) p0_transpose_item(P.w_in, P.norm_g, DM, NIN, WG, scr, it, lane);
        else p0_transpose_item(P.w_out, nullptr, DM, DM, WO, scr, it - I_IN, lane);
    }
    { const size_t n16 = (size_t)(LDH - 5664) * DM * 2 / 16; u32x4* z = (u32x4*)(WG + (size_t)5664 * DM);
      for (size_t i = (size_t)blockIdx.x * NTHREADS + tid; i < n16; i += (size_t)G * NTHREADS) z[i] = (u32x4){0u, 0u, 0u, 0u}; }
    for (int r = gw; r < MT; r += NGW) {
        const float* src = (r < MP) ? P.x_p + (size_t)r * DM : P.x_s + (size_t)(r - MP) * DM;
        const f32x4* xr = (const f32x4*)src + lane;
        f32x4 v[8]; float s = 0.f;
#pragma unroll
        for (int j = 0; j < 8; ++j) { v[j] = xr[64 * j]; s += (v[j].x * v[j].x + v[j].y * v[j].y) + (v[j].z * v[j].z + v[j].w * v[j].w); }
        const float rstd = rsqrtf(wave_sum(s) * (1.f / DM) + EPS);
        u32x2* o8 = (u32x2*)(XB + (size_t)r * DM) + lane;
#pragma unroll
        for (int j = 0; j < 8; ++j) { u32x2 w; w.x = pk2(v[j].x * rstd, v[j].y * rstd); w.y = pk2(v[j].z * rstd, v[j].w * rstd); o8[64 * j] = w; }
    }
}
DI void load8_h(const bf16* p, float (&v)[8]) { const u32x4 r = *(const u32x4*)p; v[0] = bflo(r.x); v[1] = bfhi(r.x); v[2] = bflo(r.y); v[3] = bfhi(r.y); v[4] = bflo(r.z); v[5] = bfhi(r.z); v[6] = bflo(r.w); v[7] = bfhi(r.w); }
DI void load8_f(const float* p, float (&v)[8]) { const f32x4 a = *(const f32x4*)p, b = *(const f32x4*)(p + 4); v[0] = a.x; v[1] = a.y; v[2] = a.z; v[3] = a.w; v[4] = b.x; v[5] = b.y; v[6] = b.z; v[7] = b.w; }
DI void store8_f(float* p, const float (&v)[8]) { *(f32x4*)p = (f32x4){v[0], v[1], v[2], v[3]}; *(f32x4*)(p + 4) = (f32x4){v[4], v[5], v[6], v[7]}; }
DI void norm8(float (&v)[8], const float* g, int part, float extra) {
    float ss = 0.f;
#pragma unroll
    for (int i = 0; i < 8; ++i) ss += v[i] * v[i];
    ss += __shfl_xor(ss, 1); ss += __shfl_xor(ss, 2); ss += __shfl_xor(ss, 4);
    const float rs = rsqrtf(ss * (1.f / 64.f) + EPS) * extra;
    const f32x4 g0 = *(const f32x4*)(g + part * 8), g1 = *(const f32x4*)(g + part * 8 + 4);
    v[0] *= rs * g0.x; v[1] *= rs * g0.y; v[2] *= rs * g0.z; v[3] *= rs * g0.w; v[4] *= rs * g1.x; v[5] *= rs * g1.y; v[6] *= rs * g1.z; v[7] *= rs * g1.w;
}
DI void win_items(const Params& P, int tid) {
    const bf16* H = (const bf16*)(P.ws + WS_H);
    const int ngrp = 4096 + 8192;
    for (int gt = blockIdx.x * NTHREADS + tid; gt < ((ngrp * 8 + 63) & ~63); gt += gridDim.x * NTHREADS) {
        int grp = gt >> 3; const int part = gt & 7; const bool act = grp < ngrp; if (!act) grp = 0;
        float kv[8], vv[8]; float* ok; float* ov; bool do_norm = true;
        if (grp < 4096) { const int b = grp >> 9, j = (grp >> 2) & 127, g = grp & 3; const size_t hrow = (size_t)b * SEQL + (SEQL - 128) + j;
            load8_h(H + hrow * LDH + C_KA + g * 64 + part * 8, kv); load8_h(H + hrow * LDH + C_VA + g * 64 + part * 8, vv);
            const size_t o = ((size_t)(b * 128 + j) * 4 + g) * 64 + part * 8; ok = P.out + O_WKP + o; ov = P.out + O_WVP + o; }
        else { const int s = grp - 4096, b = s >> 9, j = (s >> 2) & 127, g = s & 3;
            const size_t o = ((size_t)(b * 128 + j) * 4 + g) * 64 + part * 8; ok = P.out + O_WKS + o; ov = P.out + O_WVS + o;
            if (j < 112) { const size_t ci = ((size_t)(b * 128 + j + 16) * 4 + g) * 64 + part * 8; load8_f(P.cache_k + ci, kv); load8_f(P.cache_v + ci, vv); do_norm = false; }
            else { const size_t hrow = (size_t)MP + b * DECS + (j - 112);
                load8_h(H + hrow * LDH + C_KA + g * 64 + part * 8, kv); load8_h(H + hrow * LDH + C_VA + g * 64 + part * 8, vv); } }
        float kn[8];
#pragma unroll
        for (int i = 0; i < 8; ++i) kn[i] = kv[i];
        norm8(kn, P.kng, part, 1.f);
        if (do_norm) {
#pragma unroll
            for (int i = 0; i < 8; ++i) kv[i] = kn[i]; }
        if (act) { store8_f(ok, kv); store8_f(ov, vv); }
    }
}

constexpr int AK_STRIDE = 144, AV_STRIDE = 400, AO_STRIDE = 144;
constexpr int A_K_OFF = 0, A_V_OFF = 192 * AK_STRIDE  , A_O_OFF = A_V_OFF + 64 * AV_STRIDE  , A_END = A_O_OFF + 8 * 32 * AO_STRIDE  ;
static_assert(A_END <= LDS_BYTES, "attention LDS");
DI void att_unit(const Params& P, LAS unsigned char* lds, int tid, int u) {
    const bf16* H = (const bf16*)(P.ws + WS_H); bf16* MIX = (bf16*)(P.ws + WS_MIX);
    const int lane = tid & 63, w = tid >> 6, r32 = lane & 31, hh = lane >> 5;
    const bool sample = u >= 2048;
    int b, c, g; if (!sample) { b = u >> 8; c = (u >> 2) & 63; g = u & 3; } else { const int v = u - 2048; b = v >> 2; c = 0; g = v & 3; }
    const int j_lo = sample ? 0 : ((c >= 2) ? 0 : (2 - c) * 64), j_hi = sample ? 144 : 192;
    const size_t krow0 = sample ? (size_t)MP + b * DECS - 128 : (size_t)b * SEQL + (size_t)(c - 2) * 64;
#pragma unroll
    for (int i = 0; i < 3; ++i) { const int p = tid + NTHREADS * i, key = p >> 3, part = p & 7;
        const bool valid = key >= j_lo && key < j_hi, cached = sample && key < 128;
        float kv[8];
#pragma unroll
        for (int e = 0; e < 8; ++e) kv[e] = 0.f;
        if (valid) { if (cached) load8_f(P.cache_k + ((size_t)(b * 128 + key) * 4 + g) * 64 + part * 8, kv); else load8_h(H + (krow0 + key) * LDH + C_KA + g * 64 + part * 8, kv); }
        float kn[8];
#pragma unroll
        for (int e = 0; e < 8; ++e) kn[e] = kv[e];
        norm8(kn, P.kng, part, 1.f);
        if (!cached) {
#pragma unroll
            for (int e = 0; e < 8; ++e) kv[e] = kn[e]; }
        u32x4 o; o.x = pk2(kv[0], kv[1]); o.y = pk2(kv[2], kv[3]); o.z = pk2(kv[4], kv[5]); o.w = pk2(kv[6], kv[7]);
        *(LAS u32x4*)(lds + A_K_OFF + key * AK_STRIDE + part * 16) = o; }
#pragma unroll
    for (int it = 0; it < 2; ++it) { const int q = tid + NTHREADS * it;
        if (q < 768) { const int kp = q % 96, part = q / 96; float v0[8], v1[8];
#pragma unroll
            for (int e = 0; e < 8; ++e) { v0[e] = 0.f; v1[e] = 0.f; }
            const int k0 = 2 * kp, k1 = 2 * kp + 1;
            if (k0 >= j_lo && k0 < j_hi) { if (sample && k0 < 128) load8_f(P.cache_v + ((size_t)(b * 128 + k0) * 4 + g) * 64 + part * 8, v0); else load8_h(H + (krow0 + k0) * LDH + C_VA + g * 64 + part * 8, v0); }
            if (k1 >= j_lo && k1 < j_hi) { if (sample && k1 < 128) load8_f(P.cache_v + ((size_t)(b * 128 + k1) * 4 + g) * 64 + part * 8, v1); else load8_h(H + (krow0 + k1) * LDH + C_VA + g * 64 + part * 8, v1); }
#pragma unroll
            for (int e = 0; e < 8; ++e) *(LAS unsigned*)(lds + A_V_OFF + (8 * part + e) * AV_STRIDE + kp * 4) = pk2(v0[e], v1[e]); } }
    const int r = w >> 1, th = w & 1, tl = 32 * th + r32, hq = g * 4 + r;
    const bool qvalid = sample ? (tl < DECS) : true;
    const size_t qrow = sample ? (size_t)MP + b * DECS + (qvalid ? tl : 0) : (size_t)b * SEQL + (size_t)c * 64 + tl;
    bf16x8 qf[4];
    { float qv[4][8]; float ss = 0.f;
#pragma unroll
      for (int s = 0; s < 4; ++s) { load8_h(H + qrow * LDH + C_QA + hq * 64 + 16 * s + 8 * hh, qv[s]);
#pragma unroll
          for (int e = 0; e < 8; ++e) ss += qv[s][e] * qv[s][e]; }
      ss += __shfl_xor(ss, 32);
      const float rs = rsqrtf(ss * (1.f / 64.f) + EPS) * 0.125f;
#pragma unroll
      for (int s = 0; s < 4; ++s) { const f32x4 g0 = *(const f32x4*)(P.qng + 16 * s + 8 * hh), g1 = *(const f32x4*)(P.qng + 16 * s + 8 * hh + 4);
          u32x4 o; o.x = pk2(qv[s][0] * rs * g0.x, qv[s][1] * rs * g0.y); o.y = pk2(qv[s][2] * rs * g0.z, qv[s][3] * rs * g0.w);
          o.z = pk2(qv[s][4] * rs * g1.x, qv[s][5] * rs * g1.y); o.w = pk2(qv[s][6] * rs * g1.z, qv[s][7] * rs * g1.w); qf[s] = __builtin_bit_cast(bf16x8, o); } }
    const float sink = P.sinks[hq];
    __syncthreads();
    f32x16 oacc[2]; oacc[0] = zero16(); oacc[1] = zero16();
    float m = sink, l = 0.f;
#pragma unroll
    for (int t = 0; t < 6; ++t) {
        if (32 * t + 32 > j_lo && 32 * t < j_hi) {
            f32x16 a = zero16();
#pragma unroll
            for (int s = 0; s < 4; ++s) a = MFMA32(lds_b128(lds + A_K_OFF + (32 * t + r32) * AK_STRIDE + (16 * s + 8 * hh) * 2), qf[s], a);
            float tm = -INFINITY;
#pragma unroll
            for (int e = 0; e < 16; ++e) { const int key = 32 * t + 8 * (e >> 2) + 4 * hh + (e & 3); const bool ok = key >= j_lo && key < j_hi;
                a[e] = ok ? a[e] : -INFINITY; tm = fmaxf(tm, a[e]); }
            tm = fmaxf(tm, __shfl_xor(tm, 32));
            const float mn = fmaxf(m, tm), sc = __expf(m - mn); m = mn;
            float ls = 0.f;
#pragma unroll
            for (int e = 0; e < 16; ++e) { const float p = __expf(a[e] - m); a[e] = p; ls += p; }
            l = l * sc + ls;
#pragma unroll
            for (int e = 0; e < 16; ++e) { oacc[0][e] *= sc; oacc[1][e] *= sc; }
            const bf16x8 p0 = pack_step<0>(a), p1 = pack_step<1>(a);
#pragma unroll
            for (int dt = 0; dt < 2; ++dt) {
                LAS const unsigned char* vb = lds + A_V_OFF + (32 * dt + r32) * AV_STRIDE + (32 * t + 4 * hh) * 2;
                oacc[dt] = MFMA32(lds_2xb64(vb, vb + 16), p0, oacc[dt]);
                oacc[dt] = MFMA32(lds_2xb64(vb + 32, vb + 48), p1, oacc[dt]);
            }
        }
    }
    l += __shfl_xor(l, 32);
    l += __expf(sink - m);
    const float inv_l = 1.f / l;
    LAS unsigned char* ost = lds + A_O_OFF + w * 32 * AO_STRIDE;
#pragma unroll
    for (int dt = 0; dt < 2; ++dt)
#pragma unroll
        for (int q4 = 0; q4 < 4; ++q4) { u32x2 o; o.x = pk2(oacc[dt][4 * q4] * inv_l, oacc[dt][4 * q4 + 1] * inv_l); o.y = pk2(oacc[dt][4 * q4 + 2] * inv_l, oacc[dt][4 * q4 + 3] * inv_l);
            *(LAS u32x2*)(ost + r32 * AO_STRIDE + (32 * dt + 8 * q4 + 4 * hh) * 2) = o; }
    __syncthreads();
#pragma unroll
    for (int it = 0; it < 4; ++it) { const int row = (lane >> 3) + 8 * it, part = lane & 7, t2 = 32 * th + row;
        const bool ok = sample ? (t2 < DECS) : true;
        if (ok) { const size_t hrow = sample ? (size_t)MP + b * DECS + t2 : (size_t)b * SEQL + (size_t)c * 64 + t2;
            const u32x4 ov = *(LAS const u32x4*)(ost + row * AO_STRIDE + part * 16);
            float gv[8]; load8_h(H + hrow * LDH + C_GA + hq * 64 + part * 8, gv);
            u32x4 o; o.x = pk2(bflo(ov.x) * silu(gv[0]), bfhi(ov.x) * silu(gv[1])); o.y = pk2(bflo(ov.y) * silu(gv[2]), bfhi(ov.y) * silu(gv[3]));
            o.z = pk2(bflo(ov.z) * silu(gv[4]), bfhi(ov.z) * silu(gv[5])); o.w = pk2(bflo(ov.w) * silu(gv[6]), bfhi(ov.w) * silu(gv[7]));
            *(u32x4*)(MIX + hrow * DM + hq * 64 + part * 8) = o; } }
}
constexpr int GQ_STRIDE = 272, GT_STRIDE = 144, GO_STRIDE = 528;
constexpr int G_QD = 0, G_KD = G_QD + 64 * GQ_STRIDE  , G_KT = G_KD + 64 * GQ_STRIDE  , G_VT = G_KT + 128 * GT_STRIDE  ,
              G_ATT = G_VT + 256 * GT_STRIDE  , G_OST = G_ATT + 64 * GT_STRIDE  , G_SEG = G_OST + 64 * GO_STRIDE  , G_DV = G_SEG + 8 * 128 * 4  , G_END = G_DV + 512;
static_assert(G_END <= LDS_BYTES, "GLA LDS");
DI void gla_seq(const Params& P, LAS unsigned char* lds, int tid, int item) {
    const bf16* H = (const bf16*)(P.ws + WS_H); bf16* MIX = (bf16*)(P.ws + WS_MIX);
    const int lane = tid & 63, w = tid >> 6, r32 = lane & 31, hh = lane >> 5;
    const bool sample = item >= 32;
    const int b = sample ? (item - 32) >> 2 : item >> 2, hd = item & 3;
    const int nchunks = sample ? 1 : 64, T = sample ? DECS : 64;
    const size_t row0 = sample ? (size_t)MP + b * DECS : (size_t)b * SEQL;
    const int dp = lane, d0 = 2 * dp;
    float wg0[16], wg1[16];
#pragma unroll
    for (int r = 0; r < 16; ++r) { const f32x2_t t2 = *(const f32x2_t*)(P.w_gu + (size_t)r * 512 + hd * 128 + d0); wg0[r] = t2.x; wg1[r] = t2.y; }
    const f32x2_t bg = *(const f32x2_t*)(P.b_gate + hd * 128 + d0);
    f32x16 S[4];
#pragma unroll
    for (int mt = 0; mt < 4; ++mt) {
        if (sample) { const float* sp = P.state + ((size_t)(b * 4 + hd) * 128) * 256 + 32 * w + r32;
#pragma unroll
            for (int e = 0; e < 16; ++e) S[mt][e] = sp[(size_t)(32 * mt + 8 * (e >> 2) + 4 * hh + (e & 3)) * 256]; }
        else S[mt] = zero16();
    }
    LAS float* seg = (LAS float*)(lds + G_SEG); LAS float* dvec = (LAS float*)(lds + G_DV);
    for (int c = 0; c < nchunks; ++c) {
        const size_t rowb = row0 + (size_t)c * 64;
        float cs0[8], cs1[8]; unsigned qraw[8], kraw[8];
        float run0 = 0.f, run1 = 0.f;
#pragma unroll
        for (int i = 0; i < 8; ++i) { const int t = 8 * w + i; const bool tv = t < T;
            float la0 = 0.f, la1 = 0.f; qraw[i] = 0u; kraw[i] = 0u;
            if (tv) { const bf16* hr = H + (rowb + t) * LDH;
                float lr[16]; { float a[8], bb[8]; load8_h(hr + C_LR, a); load8_h(hr + C_LR + 8, bb);
#pragma unroll
                    for (int e = 0; e < 8; ++e) { lr[e] = a[e]; lr[8 + e] = bb[e]; } }
                float z0 = bg.x, z1 = bg.y;
#pragma unroll
                for (int r = 0; r < 16; ++r) { z0 += lr[r] * wg0[r]; z1 += lr[r] * wg1[r]; }
                la0 = (fminf(z0, 0.f) - __logf(1.f + __expf(-fabsf(z0)))) * (1.f / 16.f);
                la1 = (fminf(z1, 0.f) - __logf(1.f + __expf(-fabsf(z1)))) * (1.f / 16.f);
                qraw[i] = *(const unsigned*)(hr + C_QG + hd * 128 + d0); kraw[i] = *(const unsigned*)(hr + C_KG + hd * 128 + d0); }
            run0 += la0; run1 += la1; cs0[i] = run0; cs1[i] = run1; }
        seg[w * 128 + d0] = run0; seg[w * 128 + d0 + 1] = run1;
        u32x4 vraw[2][2];
#pragma unroll
        for (int it = 0; it < 2; ++it) { const int unit = tid + NTHREADS * it, tp = unit & 31, dvb = unit >> 5;
#pragma unroll
            for (int k = 0; k < 2; ++k) { const int t = 2 * tp + k; vraw[it][k] = (u32x4){0u, 0u, 0u, 0u};
                if (t < T) vraw[it][k] = *(const u32x4*)(H + (rowb + t) * LDH + C_VG + hd * 256 + 8 * dvb); } }
        __syncthreads();
        float pre0 = 0.f, pre1 = 0.f, tot0 = 0.f, tot1 = 0.f;
#pragma unroll
        for (int ww = 0; ww < 8; ++ww) { const f32x2_t sv = *(LAS const f32x2_t*)(seg + ww * 128 + d0); tot0 += sv.x; tot1 += sv.y; if (ww < w) { pre0 += sv.x; pre1 += sv.y; } }
        if (w == 0) { dvec[d0] = __expf(tot0); dvec[d0 + 1] = __expf(tot1); }
        unsigned ko0[4], ko1[4];
#pragma unroll
        for (int i = 0; i < 8; ++i) { const int t = 8 * w + i;
            const float bc0 = pre0 + cs0[i], bc1 = pre1 + cs1[i];
            const float q0 = bflo(qraw[i]), q1 = bfhi(qraw[i]), k0 = bflo(kraw[i]), k1 = bfhi(kraw[i]);
            const float e0 = __expf(bc0), e1 = __expf(bc1);
            *(LAS unsigned*)(lds + G_QD + t * GQ_STRIDE + dp * 4) = pk2(q0 * e0 * 0.08838834764831845f, q1 * e1 * 0.08838834764831845f);
            *(LAS unsigned*)(lds + G_KD + t * GQ_STRIDE + dp * 4) = pk2(k0 * __expf(-bc0), k1 * __expf(-bc1));
            const float o0 = k0 * __expf(tot0 - bc0), o1 = k1 * __expf(tot1 - bc1);
            if (i & 1) { ko0[i >> 1] = pk2(__uint_as_float(ko0[i >> 1]), o0); ko1[i >> 1] = pk2(__uint_as_float(ko1[i >> 1]), o1); }
            else { ko0[i >> 1] = __float_as_uint(o0); ko1[i >> 1] = __float_as_uint(o1); } }
        *(LAS u32x4*)(lds + G_KT + d0 * GT_STRIDE + w * 16) = (u32x4){ko0[0], ko0[1], ko0[2], ko0[3]};
        *(LAS u32x4*)(lds + G_KT + (d0 + 1) * GT_STRIDE + w * 16) = (u32x4){ko1[0], ko1[1], ko1[2], ko1[3]};
#pragma unroll
        for (int it = 0; it < 2; ++it) { const int unit = tid + NTHREADS * it, tp = unit & 31, dvb = unit >> 5;
            const u32x4 a = vraw[it][0], bq = vraw[it][1];
            LAS unsigned char* vb = lds + G_VT + (8 * dvb) * GT_STRIDE + tp * 4;
            *(LAS unsigned*)(vb + 0 * GT_STRIDE) = (a.x & 0xffffu) | (bq.x << 16); *(LAS unsigned*)(vb + 1 * GT_STRIDE) = (a.x >> 16) | (bq.x & 0xffff0000u);
            *(LAS unsigned*)(vb + 2 * GT_STRIDE) = (a.y & 0xffffu) | (bq.y << 16); *(LAS unsigned*)(vb + 3 * GT_STRIDE) = (a.y >> 16) | (bq.y & 0xffff0000u);
            *(LAS unsigned*)(vb + 4 * GT_STRIDE) = (a.z & 0xffffu) | (bq.z << 16); *(LAS unsigned*)(vb + 5 * GT_STRIDE) = (a.z >> 16) | (bq.z & 0xffff0000u);
            *(LAS unsigned*)(vb + 6 * GT_STRIDE) = (a.w & 0xffffu) | (bq.w << 16); *(LAS unsigned*)(vb + 7 * GT_STRIDE) = (a.w >> 16) | (bq.w & 0xffff0000u); }
        __syncthreads();
        if (w < 3) { const int it = (w >= 1), jt = (w == 2);
            f32x16 a = zero16();
#pragma unroll
            for (int s = 0; s < 8; ++s) a = MFMA32(lds_b128(lds + G_KD + (32 * jt + r32) * GQ_STRIDE + (16 * s + 8 * hh) * 2), lds_b128(lds + G_QD + (32 * it + r32) * GQ_STRIDE + (16 * s + 8 * hh) * 2), a);
            const int i = 32 * it + r32;
#pragma unroll
            for (int q4 = 0; q4 < 4; ++q4) { float v[4];
#pragma unroll
                for (int e = 0; e < 4; ++e) { const int j = 32 * jt + 8 * q4 + 4 * hh + e; v[e] = (j <= i) ? a[4 * q4 + e] : 0.f; }
                *(LAS u32x2*)(lds + G_ATT + i * GT_STRIDE + (32 * jt + 8 * q4 + 4 * hh) * 2) = (u32x2){pk2(v[0], v[1]), pk2(v[2], v[3])}; } }
        else if (w == 3) {
#pragma unroll
            for (int q4 = 0; q4 < 4; ++q4) *(LAS u32x2*)(lds + G_ATT + r32 * GT_STRIDE + (32 + 8 * q4 + 4 * hh) * 2) = (u32x2){0u, 0u}; }
        __syncthreads();
        f32x16 oacc[2]; oacc[0] = zero16(); oacc[1] = zero16();
#pragma unroll
        for (int mt = 0; mt < 4; ++mt) {
            const bf16x8 s0 = pack_step<0>(S[mt]), s1 = pack_step<1>(S[mt]);
#pragma unroll
            for (int it = 0; it < 2; ++it) { LAS const unsigned char* qb = lds + G_QD + (32 * it + r32) * GQ_STRIDE + (32 * mt + 4 * hh) * 2;
                oacc[it] = MFMA32(s0, lds_2xb64(qb, qb + 16), oacc[it]);
                oacc[it] = MFMA32(s1, lds_2xb64(qb + 32, qb + 48), oacc[it]); } }
#pragma unroll
        for (int s = 0; s < 4; ++s) { const bf16x8 va = lds_b128(lds + G_VT + (32 * w + r32) * GT_STRIDE + (16 * s + 8 * hh) * 2);
#pragma unroll
            for (int it = 0; it < 2; ++it) oacc[it] = MFMA32(va, lds_b128(lds + G_ATT + (32 * it + r32) * GT_STRIDE + (16 * s + 8 * hh) * 2), oacc[it]); }
#pragma unroll
        for (int it = 0; it < 2; ++it)
#pragma unroll
            for (int q4 = 0; q4 < 4; ++q4)
                *(LAS u32x2*)(lds + G_OST + (32 * it + r32) * GO_STRIDE + (32 * w + 8 * q4 + 4 * hh) * 2) = (u32x2){pk2(oacc[it][4 * q4], oacc[it][4 * q4 + 1]), pk2(oacc[it][4 * q4 + 2], oacc[it][4 * q4 + 3])};
#pragma unroll
        for (int mt = 0; mt < 4; ++mt) {
#pragma unroll
            for (int q4 = 0; q4 < 4; ++q4) { const f32x4 dv4 = *(LAS const f32x4*)(dvec + 32 * mt + 8 * q4 + 4 * hh);
                S[mt][4 * q4] *= dv4.x; S[mt][4 * q4 + 1] *= dv4.y; S[mt][4 * q4 + 2] *= dv4.z; S[mt][4 * q4 + 3] *= dv4.w; }
#pragma unroll
            for (int s = 0; s < 4; ++s) S[mt] = MFMA32(lds_b128(lds + G_KT + (32 * mt + r32) * GT_STRIDE + (16 * s + 8 * hh) * 2), lds_b128(lds + G_VT + (32 * w + r32) * GT_STRIDE + (16 * s + 8 * hh) * 2), S[mt]); }
        __syncthreads();
        { const int i = tid >> 3, part = tid & 7; float ov[4][8]; float ss = 0.f;
#pragma unroll
          for (int q = 0; q < 4; ++q) { const u32x4 rv = *(LAS const u32x4*)(lds + G_OST + i * GO_STRIDE + (8 * q + part) * 16);
              ov[q][0] = bflo(rv.x); ov[q][1] = bfhi(rv.x); ov[q][2] = bflo(rv.y); ov[q][3] = bfhi(rv.y); ov[q][4] = bflo(rv.z); ov[q][5] = bfhi(rv.z); ov[q][6] = bflo(rv.w); ov[q][7] = bfhi(rv.w);
#pragma unroll
              for (int e = 0; e < 8; ++e) ss += ov[q][e] * ov[q][e]; }
          ss += __shfl_xor(ss, 1); ss += __shfl_xor(ss, 2); ss += __shfl_xor(ss, 4);
          const float rs = rsqrtf(ss * (1.f / 256.f) + EPS);
          if (i < T) { const size_t hrow = rowb + i;
#pragma unroll
              for (int q = 0; q < 4; ++q) { const int cq = 8 * q + part; float gv[8]; load8_h(H + hrow * LDH + C_GG + hd * 256 + cq * 8, gv);
                  const f32x4 n0 = *(const f32x4*)(P.gng + cq * 8), n1 = *(const f32x4*)(P.gng + cq * 8 + 4);
                  u32x4 o; o.x = pk2(ov[q][0] * rs * n0.x * silu(gv[0]), ov[q][1] * rs * n0.y * silu(gv[1])); o.y = pk2(ov[q][2] * rs * n0.z * silu(gv[2]), ov[q][3] * rs * n0.w * silu(gv[3]));
                  o.z = pk2(ov[q][4] * rs * n1.x * silu(gv[4]), ov[q][5] * rs * n1.y * silu(gv[5])); o.w = pk2(ov[q][6] * rs * n1.z * silu(gv[6]), ov[q][7] * rs * n1.w * silu(gv[7]));
                  *(u32x4*)(MIX + hrow * DM + 1024 + hd * 256 + cq * 8) = o; } } }
    }
    float* so = P.out + (sample ? O_GS : O_GP) + ((size_t)(b * 4 + hd) * 128) * 256 + 32 * w + r32;
#pragma unroll
    for (int mt = 0; mt < 4; ++mt)
#pragma unroll
        for (int e = 0; e < 16; ++e) so[(size_t)(32 * mt + 8 * (e >> 2) + 4 * hh + (e & 3)) * 256] = S[mt][e];
    __syncthreads();
}
__global__ void __launch_bounds__(NTHREADS, 2) hymba_fwd(Params P) {
    extern __shared__ __attribute__((aligned(16))) unsigned char smem[];
    LAS unsigned char* lds = (LAS unsigned char*)smem;
    cg::grid_group grid = cg::this_grid();
    const int tid = threadIdx.x, G = gridDim.x, blk = blockIdx.x;
    bf16* WG = (bf16*)(P.ws + WS_WG); bf16* WO = (bf16*)(P.ws + WS_WO); bf16* XB = (bf16*)(P.ws + WS_XB); bf16* MIX = (bf16*)(P.ws + WS_MIX); bf16* H = (bf16*)(P.ws + WS_H);

    p0_prologue(P, lds, tid);
    grid.sync();

    { pg8::Gemm g{XB, WG, MT, LDH, DM}; pg8::StaticOrder S; S.init(MT, LDH, G, blk);
      pg8::EpiH E{H, LDH};
      pg8::gemm_phase<pg8::EpiH, pg8::StaticOrder, true, true>(lds, g, S, E); }
    grid.sync();

    win_items(P, tid);
    for (int it = blk; it < 96; it += G) gla_seq(P, lds, tid, it);
    { const int nb = (G > 64) ? G - 32 : G, ab = (G > 64) ? blk - 32 : blk;
      if (ab >= 0) for (int u = ab; u < 2048 + 64; u += nb) { att_unit(P, lds, tid, u); __syncthreads(); } }
    grid.sync();

    { pg8::Gemm g{MIX, WO, MT, DM, DM}; pg8::StaticOrder S; S.init(MT, DM, G, blk);
      pg8::EpiRes E{P.x_p, P.x_s, P.out, MP / 256};
      pg8::gemm_phase<pg8::EpiRes, pg8::StaticOrder, true, true>(lds, g, S, E); }
}

extern "C" void kernel_launch(void* const* d_in, const int* in_sizes, int n_in, void* d_out, int out_size, void* d_ws, size_t ws_size, hipStream_t stream) {
    static int grid_blocks = 0;
    if (grid_blocks == 0) {
        if (n_in != 14 || (size_t)out_size != O_END || ws_size < WS_END) { fprintf(stderr, "kernel_launch: unexpected shapes: n_in %d out %d ws %zu (need %zu)\n", n_in, out_size, ws_size, (size_t)WS_END); grid_blocks = -1; return; }
        int dev = 0, cus = 0, per_cu = 0;
        hipGetDevice(&dev);
        hipDeviceGetAttribute(&cus, hipDeviceAttributeMultiprocessorCount, dev);
        if (hipFuncSetAttribute((const void*)hymba_fwd, hipFuncAttributeMaxDynamicSharedMemorySize, LDS_BYTES) != hipSuccess) { fprintf(stderr, "kernel_launch: hipFuncSetAttribute failed\n"); grid_blocks = -1; return; }
        if (hipOccupancyMaxActiveBlocksPerMultiprocessor(&per_cu, (const void*)hymba_fwd, NTHREADS, LDS_BYTES) != hipSuccess || per_cu < 1) { fprintf(stderr, "kernel_launch: occupancy query says %d blocks per CU\n", per_cu); per_cu = 1; }
        (void)hipGetLastError();
        grid_blocks = cus;
        fprintf(stderr, "kernel_launch: %d CUs, %d blocks/CU by the occupancy query, grid %d\n", cus, per_cu, grid_blocks);
    }
    if (grid_blocks < 0) return;
    Params p{};
    p.x_p = (const float*)d_in[0]; p.x_s = (const float*)d_in[1]; p.cache_k = (const float*)d_in[2]; p.cache_v = (const float*)d_in[3]; p.state = (const float*)d_in[4];
    p.norm_g = (const float*)d_in[5]; p.w_in = (const float*)d_in[6]; p.w_gu = (const float*)d_in[7]; p.b_gate = (const float*)d_in[8]; p.qng = (const float*)d_in[9];
    p.kng = (const float*)d_in[10]; p.sinks = (const float*)d_in[11]; p.gng = (const float*)d_in[12]; p.w_out = (const float*)d_in[13];
    p.out = (float*)d_out; p.ws = (unsigned char*)d_ws;
    void* args[] = {&p};
    hipError_t e = hipLaunchCooperativeKernel((const void*)hymba_fwd, dim3(grid_blocks), dim3(NTHREADS), args, LDS_BYTES, stream);
    if (e != hipSuccess) fprintf(stderr, "kernel_launch: cooperative launch failed: %s (grid %d)\n", hipGetErrorString(e), grid_blocks);
}
```

```cpp
#include <hip/hip_runtime.h>
#include <hip/hip_cooperative_groups.h>
#include <cstdio>
#include <cstdint>
namespace cg = cooperative_groups;
namespace pg8 {
#define PG8_LAS __attribute__((address_space(3)))
typedef unsigned short bf16_t;
typedef short bf16x8 __attribute__((ext_vector_type(8)));
typedef float f32x4 __attribute__((ext_vector_type(4)));
typedef unsigned u32x4 __attribute__((ext_vector_type(4)));
constexpr int BM = 256, BK = 64, HALF = 128, HTB = HALF * BK * 2  , STAGE_BYTES = 8 * HTB, NXCD = 8, WGM = 8;

__host__ __device__ __forceinline__ int lds_byte(int r, int c) { const int st = (r >> 4) * 2 + (c >> 5), rr = r & 15, cc = c & 31, ob = rr * 64 + cc * 2; return st * 1024 + (ob ^ (((ob >> 9) & 1) << 5)); }
__host__ __device__ __forceinline__ void stage_rc(int b, int& R, int& C) { const int st = b / 1024, sb = b % 1024, swz = sb ^ (((sb >> 9) & 1) << 5); R = (st >> 1) * 16 + swz / 64; C = (st & 1) * 32 + (swz % 64) / 2; }
__host__ __device__ __forceinline__ int perm32(int rho) { const int n = rho >> 4, i = rho & 15; return 8 * (i >> 2) + 4 * n + (i & 3); }

struct Unit { int pm, pn; };
struct Gemm { const bf16_t* A; const bf16_t* Bt; int M, N, K; };

struct StaticOrder {
    int nM, nN, nwg, G, c;
    __host__ __device__ void init(int M, int N, int G_, int c_) { nM = M / BM; nN = N / BM; nwg = nM * nN; G = G_; c = c_; }
    __host__ __device__ bool next(int i, Unit& u) const {
        const long L = (long)i * G + c; if (L >= nwg) return false;
        int wgid = (int)L; { const int q = nwg / NXCD, r = nwg % NXCD, xcd = wgid % NXCD, off = wgid / NXCD; wgid = (xcd < r ? xcd * (q + 1) : r * (q + 1) + (xcd - r) * q) + off; }
        const int nig = WGM * nN, gid = wgid / nig, fm = gid * WGM, gsz = (nM - fm) < WGM ? (nM - fm) : WGM;
        u.pm = fm + ((wgid % nig) % gsz); u.pn = (wgid % nig) / gsz; return true;
    }
    __device__ __forceinline__ void a_ready(const Unit&) const {}
    __device__ __forceinline__ void done(const Unit&) const {}
};

__device__ __forceinline__ unsigned cvt_pk_bf16(float lo, float hi) { unsigned r; asm volatile("v_cvt_pk_bf16_f32 %0, %1, %2" : "=v"(r) : "v"(lo), "v"(hi)); return r; }
struct EpiH {
    static constexpr bool PERM = true, AFTER_DRAIN = false;
    bf16_t* O; int ldc;
    __device__ __forceinline__ void operator()(const f32x4 (&acc)[2][2][4][2], const Unit& u, int wr, int wc, int fr, int fq) const {
        const int row0 = u.pm * BM + wr * 64 + fr, col0 = u.pn * BM + wc * 32 + 8 * fq;
#pragma unroll
        for (int ai = 0; ai < 2; ++ai)
#pragma unroll
            for (int m = 0; m < 4; ++m) { bf16_t* rowp = O + (size_t)(row0 + ai * HALF + m * 16) * ldc + col0;
#pragma unroll
                for (int bj = 0; bj < 2; ++bj) { const f32x4 v0 = acc[ai][bj][m][0], v1 = acc[ai][bj][m][1];
                    u32x4 w; w.x = cvt_pk_bf16(v0[0], v0[1]); w.y = cvt_pk_bf16(v0[2], v0[3]); w.z = cvt_pk_bf16(v1[0], v1[1]); w.w = cvt_pk_bf16(v1[2], v1[3]);
                    *(u32x4*)(rowp + bj * HALF) = w; } }
    }
};
struct EpiRes {
    static constexpr bool PERM = false, AFTER_DRAIN = false;
    const float* xa; const float* xb; float* C; int split_pm;
    __device__ __forceinline__ void operator()(const f32x4 (&acc)[2][2][4][2], const Unit& u, int wr, int wc, int fr, int fq) const {
        const int lrow0 = wr * 64 + fr, col0 = u.pn * BM + wc * 32 + 4 * fq;
        const float* xt = (u.pm < split_pm) ? xa + (size_t)u.pm * BM * 2048 : xb + (size_t)(u.pm - split_pm) * BM * 2048;
        float* ct = C + (size_t)u.pm * BM * 2048;
#pragma unroll
        for (int ai = 0; ai < 2; ++ai)
#pragma unroll
            for (int m = 0; m < 4; ++m) { const size_t off = (size_t)(lrow0 + ai * HALF + m * 16) * 2048 + col0;
#pragma unroll
                for (int bj = 0; bj < 2; ++bj)
#pragma unroll
                    for (int n = 0; n < 2; ++n) *(f32x4*)(ct + off + bj * HALF + n * 16) = acc[ai][bj][m][n] + *(const f32x4*)(xt + off + bj * HALF + n * 16); }
    }
};
template <class Epi, class Sched, bool ALIGN_EPI = false, bool SP2 = false>
__device__ __forceinline__ void gemm_phase(PG8_LAS unsigned char* lds, const Gemm g, const Sched& S, const Epi& E) {
    const int tid = threadIdx.x, wid = __builtin_amdgcn_readfirstlane(tid >> 6), lane = tid & 63, wr = wid >> 2, wc = wid & 3, fr = lane & 15, fq = lane >> 4;
    const int K = g.K, nt = K / BK;
    unsigned voffA[2], voffB[2];
#pragma unroll
    for (int i = 0; i < 2; ++i) { int R, C; stage_rc(tid * 16 + i * 8192, R, C); const int Rb = Epi::PERM ? ((R & ~31) + perm32(R & 31)) : R;
        voffA[i] = (unsigned)(R * K + C) * 2u; voffB[i] = (unsigned)(Rb * K + C) * 2u; }
    const size_t kstep = (size_t)(BK * 2);
    const size_t hstep = (size_t)HALF * K * 2;
    const size_t tstep = 2 * hstep;
    const unsigned ldsw = (unsigned)wid * 1024u;
    const int aoff = lds_byte(wr * 64 + fr, fq * 8), boff = lds_byte(wc * 32 + fr, fq * 8);
#define PG8_SA(b, h) (((b) * 2 + (h)) * HTB)
#define PG8_SB(b, h) ((4 + (b) * 2 + (h)) * HTB)
#define PG8_STAGE(bufoff, gbase, voff) do { _Pragma("unroll") for (int _i = 0; _i < 2; ++_i) \
        __builtin_amdgcn_global_load_lds((const unsigned*)((const char*)(gbase) + (voff)[_i]), (PG8_LAS unsigned*)(lds + (bufoff) + ldsw + _i * 8192), 16, 0, 0); } while (0)
#define PG8_LDA(dst, b, h) do { _Pragma("unroll") for (int m = 0; m < 4; ++m) _Pragma("unroll") for (int k = 0; k < 2; ++k) dst[m][k] = *(const PG8_LAS bf16x8*)(lds + PG8_SA(b, h) + aoff + m * 2048 + k * 1024); } while (0)
#define PG8_LDB(dst, b, h) do { _Pragma("unroll") for (int n = 0; n < 2; ++n) _Pragma("unroll") for (int k = 0; k < 2; ++k) dst[n][k] = *(const PG8_LAS bf16x8*)(lds + PG8_SB(b, h) + boff + n * 2048 + k * 1024); } while (0)
#define PG8_MMA(ai, bj, At, Bt) do { __builtin_amdgcn_s_setprio(1); _Pragma("unroll") for (int m = 0; m < 4; ++m) _Pragma("unroll") for (int n = 0; n < 2; ++n) _Pragma("unroll") for (int k = 0; k < 2; ++k) \
        acc[ai][bj][m][n] = __builtin_amdgcn_mfma_f32_16x16x32_bf16(Bt[n][k], At[m][k], acc[ai][bj][m][n], 0, 0, 0); __builtin_amdgcn_s_setprio(0); } while (0)
#define PG8_WAIT_V(n) asm volatile("s_waitcnt vmcnt(" #n ")" ::: "memory")
#define PG8_WAIT_L(n) asm volatile("s_waitcnt lgkmcnt(" #n ")" ::: "memory")
#define PG8_BAR __builtin_amdgcn_s_barrier()
#define PG8_SCHED __builtin_amdgcn_sched_barrier(0)
    Unit cur, nxt; int ui = 0;
    if (!S.next(0, cur)) return;
    f32x4 acc[2][2][4][2];
#pragma unroll
    for (int a = 0; a < 2; ++a)
#pragma unroll
        for (int b = 0; b < 2; ++b)
#pragma unroll
            for (int m = 0; m < 4; ++m)
#pragma unroll
                for (int n = 0; n < 2; ++n) acc[a][b][m][n] = (f32x4){0.f, 0.f, 0.f, 0.f};
    bf16x8 At[4][2], B0[2][2], B1[2][2];
    const char* cA = (const char*)g.A + (size_t)cur.pm * tstep; const char* cB = (const char*)g.Bt + (size_t)cur.pn * tstep;
    S.a_ready(cur);
    if constexpr (SP2) {
        PG8_STAGE(PG8_SB(0, 0), cB, voffB); PG8_STAGE(PG8_SB(0, 1), cB + hstep, voffB); PG8_STAGE(PG8_SA(0, 0), cA, voffA); PG8_STAGE(PG8_SA(0, 1), cA + hstep, voffA);
        if (wr == 1) PG8_BAR;
        PG8_WAIT_V(2); PG8_BAR;
        PG8_STAGE(PG8_SB(1, 0), cB + kstep, voffB); PG8_STAGE(PG8_SA(1, 0), cA + kstep, voffA); PG8_STAGE(PG8_SB(1, 1), cB + hstep + kstep, voffB);
        PG8_WAIT_V(6); PG8_BAR;
    } else {
        PG8_STAGE(PG8_SB(0, 0), cB, voffB); PG8_STAGE(PG8_SA(0, 0), cA, voffA); PG8_STAGE(PG8_SB(0, 1), cB + hstep, voffB); PG8_STAGE(PG8_SA(0, 1), cA + hstep, voffA);
        if (wr == 1) PG8_BAR;
        PG8_WAIT_V(4); PG8_BAR;
        PG8_STAGE(PG8_SB(1, 0), cB + kstep, voffB); PG8_STAGE(PG8_SA(1, 0), cA + kstep, voffA); PG8_STAGE(PG8_SB(1, 1), cB + hstep + kstep, voffB);
        PG8_WAIT_V(6); PG8_BAR;
    }
    for (;;) {
        const bool has_next = S.next(ui + 1, nxt);
        const char* nA = has_next ? (const char*)g.A + (size_t)nxt.pm * tstep : cA; const char* nB = has_next ? (const char*)g.Bt + (size_t)nxt.pn * tstep : cB;
        for (int t = 0; t < nt; t += 2) {
            const bool last = (t == nt - 2);
            const char* a1 = cA + (size_t)(t + 1) * kstep;
            const char* a2 = last ? nA : cA + (size_t)(t + 2) * kstep; const char* b2 = last ? nB : cB + (size_t)(t + 2) * kstep;
            const char* a3 = a2 + kstep; const char* b3 = b2 + kstep;
            if (last && has_next) S.a_ready(nxt);
            if constexpr (SP2) {
            PG8_LDB(B0, 0, 0); PG8_LDB(B1, 0, 1); PG8_SCHED; PG8_LDA(At, 0, 0); PG8_STAGE(PG8_SA(1, 1), a1 + hstep, voffA);
            PG8_WAIT_V(8); PG8_WAIT_L(0); PG8_BAR; PG8_MMA(0, 0, At, B0); PG8_MMA(0, 1, At, B1); PG8_BAR; PG8_SCHED;
            PG8_LDA(At, 0, 1); PG8_STAGE(PG8_SB(0, 0), b2, voffB); PG8_STAGE(PG8_SB(0, 1), b2 + hstep, voffB); PG8_STAGE(PG8_SA(0, 0), a2, voffA);
            PG8_WAIT_V(8); PG8_WAIT_L(0); PG8_BAR; PG8_MMA(1, 0, At, B0); PG8_MMA(1, 1, At, B1); PG8_BAR; PG8_SCHED;
            PG8_LDB(B0, 1, 0); PG8_LDB(B1, 1, 1); PG8_SCHED; PG8_LDA(At, 1, 0); PG8_STAGE(PG8_SA(0, 1), a2 + hstep, voffA);
            PG8_WAIT_V(8); PG8_WAIT_L(0); PG8_BAR; PG8_MMA(0, 0, At, B0); PG8_MMA(0, 1, At, B1); PG8_BAR; PG8_SCHED;
            PG8_LDA(At, 1, 1); PG8_STAGE(PG8_SB(1, 0), b3, voffB); PG8_STAGE(PG8_SB(1, 1), b3 + hstep, voffB); PG8_STAGE(PG8_SA(1, 0), a3, voffA);
            PG8_WAIT_V(8); PG8_WAIT_L(0); PG8_BAR; PG8_MMA(1, 0, At, B0); PG8_MMA(1, 1, At, B1); PG8_BAR; PG8_SCHED;
            } else {
            PG8_LDB(B0, 0, 0); PG8_SCHED; PG8_LDA(At, 0, 0); PG8_STAGE(PG8_SA(1, 1), a1 + hstep, voffA);
            PG8_WAIT_L(8); PG8_BAR; PG8_WAIT_L(0); PG8_MMA(0, 0, At, B0); PG8_BAR; PG8_SCHED;
            PG8_LDB(B1, 0, 1); PG8_STAGE(PG8_SB(0, 0), b2, voffB);
            PG8_BAR; PG8_WAIT_L(0); PG8_MMA(0, 1, At, B1); PG8_BAR;
            PG8_LDA(At, 0, 1); PG8_STAGE(PG8_SA(0, 0), a2, voffA);
            PG8_BAR; PG8_WAIT_L(0); PG8_MMA(1, 0, At, B0); PG8_BAR; PG8_SCHED;
            PG8_STAGE(PG8_SB(0, 1), b2 + hstep, voffB);
            PG8_WAIT_V(6); PG8_BAR; PG8_MMA(1, 1, At, B1); PG8_BAR;
            PG8_LDB(B0, 1, 0); PG8_SCHED; PG8_LDA(At, 1, 0); PG8_STAGE(PG8_SA(0, 1), a2 + hstep, voffA);
            PG8_WAIT_L(8); PG8_BAR; PG8_WAIT_L(0); PG8_MMA(0, 0, At, B0); PG8_BAR; PG8_SCHED;
            PG8_LDB(B1, 1, 1); PG8_STAGE(PG8_SB(1, 0), b3, voffB);
            PG8_BAR; PG8_WAIT_L(0); PG8_MMA(0, 1, At, B1); PG8_BAR;
            PG8_LDA(At, 1, 1); PG8_STAGE(PG8_SA(1, 0), a3, voffA);
            PG8_BAR; PG8_WAIT_L(0); PG8_MMA(1, 0, At, B0); PG8_BAR; PG8_SCHED;
            PG8_STAGE(PG8_SB(1, 1), b3 + hstep, voffB);
            PG8_WAIT_V(6); PG8_BAR; PG8_MMA(1, 1, At, B1); PG8_BAR;
            }
        }
        if constexpr (ALIGN_EPI) { if (wr == 0) PG8_BAR; }
        if constexpr (!Epi::AFTER_DRAIN) { E(acc, cur, wr, wc, fr, fq); S.done(cur); }
        if (!has_next) break;
#pragma unroll
        for (int a = 0; a < 2; ++a)
#pragma unroll
            for (int b = 0; b < 2; ++b)
#pragma unroll
                for (int m = 0; m < 4; ++m)
#pragma unroll
                    for (int n = 0; n < 2; ++n) acc[a][b][m][n] = (f32x4){0.f, 0.f, 0.f, 0.f};
        cur = nxt; cA = nA; cB = nB; ++ui;
        if constexpr (ALIGN_EPI) { if (wr == 1) PG8_BAR; }
    }
    PG8_WAIT_V(0);
    if constexpr (!ALIGN_EPI) { if (wr == 0) PG8_BAR; }
    PG8_BAR;
    if constexpr (Epi::AFTER_DRAIN) { E.fused(acc, cur, wr, wc, fr, fq, lds, wid, lane); S.done(cur); }
#undef PG8_SA
#undef PG8_SB
#undef PG8_STAGE
#undef PG8_LDA
#undef PG8_LDB
#undef PG8_MMA
#undef PG8_WAIT_V
#undef PG8_WAIT_L
#undef PG8_BAR
#undef PG8_SCHED
}
}
#define LAS __attribute__((address_space(3)))
#define DI __device__ __forceinline__
typedef unsigned short bf16;
typedef short bf16x8 __attribute__((ext_vector_type(8)));
typedef float f32x4 __attribute__((ext_vector_type(4)));
typedef float f32x16 __attribute__((ext_vector_type(16)));
typedef unsigned u32x4 __attribute__((ext_vector_type(4)));
typedef unsigned u32x2 __attribute__((ext_vector_type(2)));
typedef float f32x2_t __attribute__((ext_vector_type(2)));
typedef __bf16 bf16x2_t __attribute__((ext_vector_type(2)));

constexpr int DM = 2048, NB = 8, SEQL = 4096, DECB = 16, DECS = 16;
constexpr int MP = NB * SEQL, MS = DECB * DECS, MT = MP + MS;
constexpr int NIN = 5648, LDH = 5888;
constexpr int C_QA = 0, C_KA = 1024, C_VA = 1280, C_GA = 1536, C_QG = 2560, C_KG = 3072, C_VG = 3584, C_GG = 4608, C_LR = 5632;
constexpr float EPS = 1e-6f;
constexpr size_t MiB = 1u << 20;
constexpr size_t WS_WG = 0, WS_WO = 24 * MiB, WS_XB = 32 * MiB, WS_MIX = 161 * MiB, WS_H = 290 * MiB, WS_L = 662 * MiB, WS_D = 694 * MiB, WS_END = 695 * MiB;
static_assert(WS_H + (size_t)MT * LDH * 2 <= WS_L && (size_t)LDH * DM * 2 <= WS_WO && WS_XB + (size_t)MT * DM * 2 <= WS_MIX && WS_MIX + (size_t)MT * DM * 2 <= WS_H, "ws map");
constexpr size_t O_YP = 0, O_YS = (size_t)MP * DM, O_WKP = O_YS + (size_t)MS * DM, O_WVP = O_WKP + 262144, O_GP = O_WVP + 262144,
                 O_WKS = O_GP + 1048576, O_WVS = O_WKS + 524288, O_GS = O_WVS + 524288, O_END = O_GS + 2097152;
constexpr int LDS_BYTES = 147456;
constexpr int NTHREADS = 512;

struct Params {
    const float *x_p, *x_s, *cache_k, *cache_v, *state, *norm_g, *w_in, *w_gu, *b_gate, *qng, *kng, *sinks, *gng, *w_out;
    float* out; unsigned char* ws;
};

DI unsigned pk2(float lo, float hi) { f32x2_t v = {lo, hi}; bf16x2_t b = __builtin_convertvector(v, bf16x2_t); return __builtin_bit_cast(unsigned, b); }
DI float bflo(unsigned u) { return __uint_as_float(u << 16); }
DI float bfhi(unsigned u) { return __uint_as_float(u & 0xffff0000u); }
DI float wave_sum(float v) {
#pragma unroll
    for (int o = 1; o < 64; o <<= 1) v += __shfl_xor(v, o);
    return v;
}
DI float silu(float x) { return x / (1.f + __expf(-x)); }
#define MFMA32(a, b, c) __builtin_amdgcn_mfma_f32_32x32x16_bf16((a), (b), (c), 0, 0, 0)
DI f32x16 zero16() { f32x16 z;
#pragma unroll
    for (int i = 0; i < 16; ++i) z[i] = 0.f;
    return z; }
template <int S> DI bf16x8 pack_step(const f32x16& x) {
    u32x4 p; p.x = pk2(x[8 * S + 0], x[8 * S + 1]); p.y = pk2(x[8 * S + 2], x[8 * S + 3]); p.z = pk2(x[8 * S + 4], x[8 * S + 5]); p.w = pk2(x[8 * S + 6], x[8 * S + 7]);
    return __builtin_bit_cast(bf16x8, p);
}
DI bf16x8 lds_b128(LAS const unsigned char* p) { return *(LAS const bf16x8*)p; }
DI bf16x8 lds_2xb64(LAS const unsigned char* p0, LAS const unsigned char* p1) {
    const u32x2 a = *(LAS const u32x2*)p0, b = *(LAS const u32x2*)p1; u32x4 r; r.x = a.x; r.y = a.y; r.z = b.x; r.w = b.y; return __builtin_bit_cast(bf16x8, r);
}

DI void p0_transpose_item(const float* W, const float* rs, int K, int N, bf16* WT, LAS float* scr, int item, int lane) {
    const int nblk = (N + 31) / 32, kb = item / nblk, nb = item % nblk, k0 = 64 * kb, n0 = 32 * nb;
#pragma unroll 8
    for (int i = 0; i < 32; ++i) { const int kk = 2 * i + (lane >> 5), n = n0 + (lane & 31);
        float v = (n < N) ? W[(size_t)(k0 + kk) * N + n] : 0.f; if (rs) v *= rs[k0 + kk];
        scr[kk * 33 + (lane & 31)] = v; }
    asm volatile("s_waitcnt lgkmcnt(0)" ::: "memory");
    const int c = lane & 7;
#pragma unroll
    for (int j = 0; j < 4; ++j) { const int n = (lane >> 3) + 8 * j; LAS const float* s = scr + (8 * c) * 33 + n;
        u32x4 o; o.x = pk2(s[0 * 33], s[1 * 33]); o.y = pk2(s[2 * 33], s[3 * 33]); o.z = pk2(s[4 * 33], s[5 * 33]); o.w = pk2(s[6 * 33], s[7 * 33]);
        *(u32x4*)(WT + (size_t)(n0 + n) * K + k0 + 8 * c) = o; }
    asm volatile("s_waitcnt lgkmcnt(0)" ::: "memory");
}
DI void p0_prologue(const Params& P, LAS unsigned char* lds, int tid) {
    const int lane = tid & 63, wave = tid >> 6, G = gridDim.x;
    const int gw = blockIdx.x * 8 + wave, NGW = G * 8;
    LAS float* scr = (LAS float*)(lds + wave * 16384);
    bf16* WG = (bf16*)(P.ws + WS_WG); bf16* WO = (bf16*)(P.ws + WS_WO); bf16* XB = (bf16*)(P.ws + WS_XB);
    constexpr int I_IN = (DM / 64) * ((NIN + 31) / 32), I_OUT = (DM / 64) * (DM / 32);
    for (int it = gw; it < I_IN + I_OUT; it += NGW) {
        if (it < I_IN) p0_transpose_item(P.w_in, P.norm_g, DM, NIN, WG, scr, it, lane);
        else p0_transpose_item(P.w_out, nullptr, DM, DM, WO, scr, it - I_IN, lane);
    }
    { const size_t n16 = (size_t)(LDH - 5664) * DM * 2 / 16; u32x4* z = (u32x4*)(WG + (size_t)5664 * DM);
      for (size_t i = (size_t)blockIdx.x * NTHREADS + tid; i < n16; i += (size_t)G * NTHREADS) z[i] = (u32x4){0u, 0u, 0u, 0u}; }
    for (int r = gw; r < MT; r += NGW) {
        const float* src = (r < MP) ? P.x_p + (size_t)r * DM : P.x_s + (size_t)(r - MP) * DM;
        const f32x4* xr = (const f32x4*)src + lane;
        f32x4 v[8]; float s = 0.f;
#pragma unroll
        for (int j = 0; j < 8; ++j) { v[j] = xr[64 * j]; s += (v[j].x * v[j].x + v[j].y * v[j].y) + (v[j].z * v[j].z + v[j].w * v[j].w); }
        const float rstd = rsqrtf(wave_sum(s) * (1.f / DM) + EPS);
        u32x2* o8 = (u32x2*)(XB + (size_t)r * DM) + lane;
#pragma unroll
        for (int j = 0; j < 8; ++j) { u32x2 w; w.x = pk2(v[j].x * rstd, v[j].y * rstd); w.y = pk2(v[j].z * rstd, v[j].w * rstd); o8[64 * j] = w; }
    }
}
DI void load8_h(const bf16* p, float (&v)[8]) { const u32x4 r = *(const u32x4*)p; v[0] = bflo(r.x); v[1] = bfhi(r.x); v[2] = bflo(r.y); v[3] = bfhi(r.y); v[4] = bflo(r.z); v[5] = bfhi(r.z); v[6] = bflo(r.w); v[7] = bfhi(r.w); }
DI void load8_f(const float* p, float (&v)[8]) { const f32x4 a = *(const f32x4*)p, b = *(const f32x4*)(p + 4); v[0] = a.x; v[1] = a.y; v[2] = a.z; v[3] = a.w; v[4] = b.x; v[5] = b.y; v[6] = b.z; v[7] = b.w; }
DI void store8_f(float* p, const float (&v)[8]) { *(f32x4*)p = (f32x4){v[0], v[1], v[2], v[3]}; *(f32x4*)(p + 4) = (f32x4){v[4], v[5], v[6], v[7]}; }
DI void norm8(float (&v)[8], const float* g, int part, float extra) {
    float ss = 0.f;
#pragma unroll
    for (int i = 0; i < 8; ++i) ss += v[i] * v[i];
    ss += __shfl_xor(ss, 1); ss += __shfl_xor(ss, 2); ss += __shfl_xor(ss, 4);
    const float rs = rsqrtf(ss * (1.f / 64.f) + EPS) * extra;
    const f32x4 g0 = *(const f32x4*)(g + part * 8), g1 = *(const f32x4*)(g + part * 8 + 4);
    v[0] *= rs * g0.x; v[1] *= rs * g0.y; v[2] *= rs * g0.z; v[3] *= rs * g0.w; v[4] *= rs * g1.x; v[5] *= rs * g1.y; v[6] *= rs * g1.z; v[7] *= rs * g1.w;
}
DI void win_items(const Params& P, int tid) {
    const bf16* H = (const bf16*)(P.ws + WS_H);
    const int ngrp = 4096 + 8192;
    for (int gt = blockIdx.x * NTHREADS + tid; gt < ((ngrp * 8 + 63) & ~63); gt += gridDim.x * NTHREADS) {
        int grp = gt >> 3; const int part = gt & 7; const bool act = grp < ngrp; if (!act) grp = 0;
        float kv[8], vv[8]; float* ok; float* ov; bool do_norm = true;
        if (grp < 4096) { const int b = grp >> 9, j = (grp >> 2) & 127, g = grp & 3; const size_t hrow = (size_t)b * SEQL + (SEQL - 128) + j;
            load8_h(H + hrow * LDH + C_KA + g * 64 + part * 8, kv); load8_h(H + hrow * LDH + C_VA + g * 64 + part * 8, vv);
            const size_t o = ((size_t)(b * 128 + j) * 4 + g) * 64 + part * 8; ok = P.out + O_WKP + o; ov = P.out + O_WVP + o; }
        else { const int s = grp - 4096, b = s >> 9, j = (s >> 2) & 127, g = s & 3;
            const size_t o = ((size_t)(b * 128 + j) * 4 + g) * 64 + part * 8; ok = P.out + O_WKS + o; ov = P.out + O_WVS + o;
            if (j < 112) { const size_t ci = ((size_t)(b * 128 + j + 16) * 4 + g) * 64 + part * 8; load8_f(P.cache_k + ci, kv); load8_f(P.cache_v + ci, vv); do_norm = false; }
            else { const size_t hrow = (size_t)MP + b * DECS + (j - 112);
                load8_h(H + hrow * LDH + C_KA + g * 64 + part * 8, kv); load8_h(H + hrow * LDH + C_VA + g * 64 + part * 8, vv); } }
        float kn[8];
#pragma unroll
        for (int i = 0; i < 8; ++i) kn[i] = kv[i];
        norm8(kn, P.kng, part, 1.f);
        if (do_norm) {
#pragma unroll
            for (int i = 0; i < 8; ++i) kv[i] = kn[i]; }
        if (act) { store8_f(ok, kv); store8_f(ov, vv); }
    }
}

constexpr int AK_STRIDE = 144, AV_STRIDE = 400, AO_STRIDE = 144;
constexpr int A_K_OFF = 0, A_V_OFF = 192 * AK_STRIDE  , A_O_OFF = A_V_OFF + 64 * AV_STRIDE  , A_END = A_O_OFF + 8 * 32 * AO_STRIDE  ;
static_assert(A_END <= LDS_BYTES, "attention LDS");
DI void att_unit(const Params& P, LAS unsigned char* lds, int tid, int u) {
    asm volatile("" : "+v"(tid));
    const bf16* H = (const bf16*)(P.ws + WS_H); bf16* MIX = (bf16*)(P.ws + WS_MIX);
    const int lane = tid & 63, w = tid >> 6, r32 = lane & 31, hh = lane >> 5;
    const bool sample = u >= 2048;
    int b, c, g; if (!sample) { b = u >> 8; c = (u >> 2) & 63; g = u & 3; } else { const int v = u - 2048; b = v >> 2; c = 0; g = v & 3; }
    const int j_lo = sample ? 0 : ((c >= 2) ? 0 : (2 - c) * 64), j_hi = sample ? 144 : 192;
    const size_t krow0 = sample ? (size_t)MP + b * DECS - 128 : (size_t)b * SEQL + (size_t)(c - 2) * 64;
#pragma unroll
    for (int i = 0; i < 3; ++i) { const int p = tid + NTHREADS * i, key = p >> 3, part = p & 7;
        const bool valid = key >= j_lo && key < j_hi, cached = sample && key < 128;
        float kv[8];
#pragma unroll
        for (int e = 0; e < 8; ++e) kv[e] = 0.f;
        if (valid) { if (cached) load8_f(P.cache_k + ((size_t)(b * 128 + key) * 4 + g) * 64 + part * 8, kv); else load8_h(H + (krow0 + key) * LDH + C_KA + g * 64 + part * 8, kv); }
        float kn[8];
#pragma unroll
        for (int e = 0; e < 8; ++e) kn[e] = kv[e];
        norm8(kn, P.kng, part, 1.f);
        if (!cached) {
#pragma unroll
            for (int e = 0; e < 8; ++e) kv[e] = kn[e]; }
        u32x4 o; o.x = pk2(kv[0], kv[1]); o.y = pk2(kv[2], kv[3]); o.z = pk2(kv[4], kv[5]); o.w = pk2(kv[6], kv[7]);
        *(LAS u32x4*)(lds + A_K_OFF + key * AK_STRIDE + part * 16) = o; }
#pragma unroll
    for (int it = 0; it < 2; ++it) { const int q = tid + NTHREADS * it;
        if (q < 768) { const int kp = q % 96, part = q / 96; float v0[8], v1[8];
#pragma unroll
            for (int e = 0; e < 8; ++e) { v0[e] = 0.f; v1[e] = 0.f; }
            const int k0 = 2 * kp, k1 = 2 * kp + 1;
            if (k0 >= j_lo && k0 < j_hi) { if (sample && k0 < 128) load8_f(P.cache_v + ((size_t)(b * 128 + k0) * 4 + g) * 64 + part * 8, v0); else load8_h(H + (krow0 + k0) * LDH + C_VA + g * 64 + part * 8, v0); }
            if (k1 >= j_lo && k1 < j_hi) { if (sample && k1 < 128) load8_f(P.cache_v + ((size_t)(b * 128 + k1) * 4 + g) * 64 + part * 8, v1); else load8_h(H + (krow0 + k1) * LDH + C_VA + g * 64 + part * 8, v1); }
#pragma unroll
            for (int e = 0; e < 8; ++e) *(LAS unsigned*)(lds + A_V_OFF + (8 * part + e) * AV_STRIDE + kp * 4) = pk2(v0[e], v1[e]); } }
    const int r = w >> 1, th = w & 1, tl = 32 * th + r32, hq = g * 4 + r;
    const bool qvalid = sample ? (tl < DECS) : true;
    const size_t qrow = sample ? (size_t)MP + b * DECS + (qvalid ? tl : 0) : (size_t)b * SEQL + (size_t)c * 64 + tl;
    bf16x8 qf[4];
    { float qv[4][8]; float ss = 0.f;
#pragma unroll
      for (int s = 0; s < 4; ++s) { load8_h(H + qrow * LDH + C_QA + hq * 64 + 16 * s + 8 * hh, qv[s]);
#pragma unroll
          for (int e = 0; e < 8; ++e) ss += qv[s][e] * qv[s][e]; }
      ss += __shfl_xor(ss, 32);
      const float rs = rsqrtf(ss * (1.f / 64.f) + EPS) * 0.125f;
#pragma unroll
      for (int s = 0; s < 4; ++s) { const f32x4 g0 = *(const f32x4*)(P.qng + 16 * s + 8 * hh), g1 = *(const f32x4*)(P.qng + 16 * s + 8 * hh + 4);
          u32x4 o; o.x = pk2(qv[s][0] * rs * g0.x, qv[s][1] * rs * g0.y); o.y = pk2(qv[s][2] * rs * g0.z, qv[s][3] * rs * g0.w);
          o.z = pk2(qv[s][4] * rs * g1.x, qv[s][5] * rs * g1.y); o.w = pk2(qv[s][6] * rs * g1.z, qv[s][7] * rs * g1.w); qf[s] = __builtin_bit_cast(bf16x8, o); } }
    const float sink = P.sinks[hq];
    __syncthreads();
    f32x16 oacc[2]; oacc[0] = zero16(); oacc[1] = zero16();
    float m = sink, l = 0.f;
#pragma unroll
    for (int t = 0; t < 6; ++t) {
        if (32 * t + 32 > j_lo && 32 * t < j_hi) {
            f32x16 a = zero16();
#pragma unroll
            for (int s = 0; s < 4; ++s) a = MFMA32(lds_b128(lds + A_K_OFF + (32 * t + r32) * AK_STRIDE + (16 * s + 8 * hh) * 2), qf[s], a);
            float tm = -INFINITY;
#pragma unroll
            for (int e = 0; e < 16; ++e) { const int key = 32 * t + 8 * (e >> 2) + 4 * hh + (e & 3); const bool ok = key >= j_lo && key < j_hi;
                a[e] = ok ? a[e] : -INFINITY; tm = fmaxf(tm, a[e]); }
            tm = fmaxf(tm, __shfl_xor(tm, 32));
            const float mn = fmaxf(m, tm), sc = __expf(m - mn); m = mn;
            float ls = 0.f;
#pragma unroll
            for (int e = 0; e < 16; ++e) { const float p = __expf(a[e] - m); a[e] = p; ls += p; }
            l = l * sc + ls;
#pragma unroll
            for (int e = 0; e < 16; ++e) { oacc[0][e] *= sc; oacc[1][e] *= sc; }
            const bf16x8 p0 = pack_step<0>(a), p1 = pack_step<1>(a);
#pragma unroll
            for (int dt = 0; dt < 2; ++dt) {
                LAS const unsigned char* vb = lds + A_V_OFF + (32 * dt + r32) * AV_STRIDE + (32 * t + 4 * hh) * 2;
                oacc[dt] = MFMA32(lds_2xb64(vb, vb + 16), p0, oacc[dt]);
                oacc[dt] = MFMA32(lds_2xb64(vb + 32, vb + 48), p1, oacc[dt]);
            }
        }
    }
    l += __shfl_xor(l, 32);
    l += __expf(sink - m);
    const float inv_l = 1.f / l;
    LAS unsigned char* ost = lds + A_O_OFF + w * 32 * AO_STRIDE;
#pragma unroll
    for (int dt = 0; dt < 2; ++dt)
#pragma unroll
        for (int q4 = 0; q4 < 4; ++q4) { u32x2 o; o.x = pk2(oacc[dt][4 * q4] * inv_l, oacc[dt][4 * q4 + 1] * inv_l); o.y = pk2(oacc[dt][4 * q4 + 2] * inv_l, oacc[dt][4 * q4 + 3] * inv_l);
            *(LAS u32x2*)(ost + r32 * AO_STRIDE + (32 * dt + 8 * q4 + 4 * hh) * 2) = o; }
    __syncthreads();
#pragma unroll
    for (int it = 0; it < 4; ++it) { const int row = (lane >> 3) + 8 * it, part = lane & 7, t2 = 32 * th + row;
        const bool ok = sample ? (t2 < DECS) : true;
        if (ok) { const size_t hrow = sample ? (size_t)MP + b * DECS + t2 : (size_t)b * SEQL + (size_t)c * 64 + t2;
            const u32x4 ov = *(LAS const u32x4*)(ost + row * AO_STRIDE + part * 16);
            float gv[8]; load8_h(H + hrow * LDH + C_GA + hq * 64 + part * 8, gv);
            u32x4 o; o.x = pk2(bflo(ov.x) * silu(gv[0]), bfhi(ov.x) * silu(gv[1])); o.y = pk2(bflo(ov.y) * silu(gv[2]), bfhi(ov.y) * silu(gv[3]));
            o.z = pk2(bflo(ov.z) * silu(gv[4]), bfhi(ov.z) * silu(gv[5])); o.w = pk2(bflo(ov.w) * silu(gv[6]), bfhi(ov.w) * silu(gv[7]));
            *(u32x4*)(MIX + hrow * DM + hq * 64 + part * 8) = o; } }
}
constexpr int GQ_STRIDE = 272, GT_STRIDE = 144, GO_STRIDE = 528;
constexpr int G_QD = 0, G_KD = G_QD + 64 * GQ_STRIDE  , G_KT = G_KD + 64 * GQ_STRIDE  , G_VT = G_KT + 128 * GT_STRIDE  ,
              G_ATT = G_VT + 256 * GT_STRIDE  , G_OST = G_ATT + 64 * GT_STRIDE  , G_SEG = G_OST + 64 * GO_STRIDE  , G_DV = G_SEG + 8 * 128 * 4  , G_END = G_DV + 512;
static_assert(G_END <= LDS_BYTES, "GLA LDS");
template <bool FULL>
DI void gla_run(const Params& P, LAS unsigned char* lds, int tid, int kind, int item) {
    asm volatile("" : "+v"(tid));
    const bf16* H = (const bf16*)(P.ws + WS_H); bf16* MIX = (bf16*)(P.ws + WS_MIX);
    float* LBUF = (float*)(P.ws + WS_L); float* DBUF = (float*)(P.ws + WS_D);
    const int lane = tid & 63, w = tid >> 6, r32 = lane & 31, hh = lane >> 5;
    const bool sample = kind == 2;
    const int grp = sample ? 0 : (item & 7), bh = sample ? item : (item >> 3);
    const int b = bh >> 2, hd = bh & 3;
    const int c_begin = sample ? 0 : 8 * grp, nchunks = sample ? 1 : 8, T = sample ? DECS : 64;
    const size_t row0 = sample ? (size_t)MP + b * DECS : (size_t)b * SEQL;
    const int dp = lane, d0 = 2 * dp;
    float wg0[16], wg1[16];
#pragma unroll
    for (int r = 0; r < 16; ++r) { const f32x2_t t2 = *(const f32x2_t*)(P.w_gu + (size_t)r * 512 + hd * 128 + d0); wg0[r] = t2.x; wg1[r] = t2.y; }
    const f32x2_t bg = *(const f32x2_t*)(P.b_gate + hd * 128 + d0);
    f32x16 S[4];
#pragma unroll
    for (int mt = 0; mt < 4; ++mt) S[mt] = zero16();
    if (sample) { const float* sp = P.state + ((size_t)bh * 128) * 256 + 32 * w + r32;
#pragma unroll
        for (int mt = 0; mt < 4; ++mt)
#pragma unroll
            for (int e = 0; e < 16; ++e) S[mt][e] = sp[(size_t)(32 * mt + 8 * (e >> 2) + 4 * hh + (e & 3)) * 256]; }
    else if (FULL) {
        for (int gp = 0; gp < grp; ++gp) { const float* lp = LBUF + ((size_t)(bh * 8 + gp) * 128) * 256 + 32 * w + r32; const float* dpv = DBUF + (size_t)(bh * 8 + gp) * 128;
#pragma unroll
            for (int mt = 0; mt < 4; ++mt)
#pragma unroll
                for (int q4 = 0; q4 < 4; ++q4) { const f32x4 d4 = *(const f32x4*)(dpv + 32 * mt + 8 * q4 + 4 * hh);
#pragma unroll
                    for (int e = 0; e < 4; ++e) S[mt][4 * q4 + e] = S[mt][4 * q4 + e] * d4[e] + lp[(size_t)(32 * mt + 8 * q4 + 4 * hh + e) * 256]; } } }
    float gt0 = 0.f, gt1 = 0.f;
    LAS float* seg = (LAS float*)(lds + G_SEG); LAS float* dvec = (LAS float*)(lds + G_DV);
    for (int c = c_begin; c < c_begin + nchunks; ++c) {
        const size_t rowb = row0 + (size_t)c * 64;
        float cs0[8], cs1[8]; unsigned qraw[8], kraw[8];
        float run0 = 0.f, run1 = 0.f;
#pragma unroll
        for (int i = 0; i < 8; ++i) { const int t = 8 * w + i; const bool tv = t < T;
            float la0 = 0.f, la1 = 0.f; qraw[i] = 0u; kraw[i] = 0u;
            if (tv) { const bf16* hr = H + (rowb + t) * LDH;
                float lr[16]; { float a[8], bb[8]; load8_h(hr + C_LR, a); load8_h(hr + C_LR + 8, bb);
#pragma unroll
                    for (int e = 0; e < 8; ++e) { lr[e] = a[e]; lr[8 + e] = bb[e]; } }
                float z0 = bg.x, z1 = bg.y;
#pragma unroll
                for (int r = 0; r < 16; ++r) { z0 += lr[r] * wg0[r]; z1 += lr[r] * wg1[r]; }
                la0 = (fminf(z0, 0.f) - __logf(1.f + __expf(-fabsf(z0)))) * (1.f / 16.f);
                la1 = (fminf(z1, 0.f) - __logf(1.f + __expf(-fabsf(z1)))) * (1.f / 16.f);
                if (FULL) qraw[i] = *(const unsigned*)(hr + C_QG + hd * 128 + d0); kraw[i] = *(const unsigned*)(hr + C_KG + hd * 128 + d0); }
            run0 += la0; run1 += la1; cs0[i] = run0; cs1[i] = run1; }
        seg[w * 128 + d0] = run0; seg[w * 128 + d0 + 1] = run1;
        u32x4 vraw[2][2];
#pragma unroll
        for (int it = 0; it < 2; ++it) { const int unit = tid + NTHREADS * it, tp = unit & 31, dvb = unit >> 5;
#pragma unroll
            for (int k = 0; k < 2; ++k) { const int t = 2 * tp + k; vraw[it][k] = (u32x4){0u, 0u, 0u, 0u};
                if (t < T) vraw[it][k] = *(const u32x4*)(H + (rowb + t) * LDH + C_VG + hd * 256 + 8 * dvb); } }
        __syncthreads();
        float pre0 = 0.f, pre1 = 0.f, tot0 = 0.f, tot1 = 0.f;
#pragma unroll
        for (int ww = 0; ww < 8; ++ww) { const f32x2_t sv = *(LAS const f32x2_t*)(seg + ww * 128 + d0); tot0 += sv.x; tot1 += sv.y; if (ww < w) { pre0 += sv.x; pre1 += sv.y; } }
        if (w == 0) { dvec[d0] = __expf(tot0); dvec[d0 + 1] = __expf(tot1); }
        gt0 += tot0; gt1 += tot1;
        unsigned ko0[4], ko1[4];
#pragma unroll
        for (int i = 0; i < 8; ++i) { const int t = 8 * w + i;
            const float bc0 = pre0 + cs0[i], bc1 = pre1 + cs1[i];
            const float q0 = bflo(qraw[i]), q1 = bfhi(qraw[i]), k0 = bflo(kraw[i]), k1 = bfhi(kraw[i]);
            const float e0 = __expf(bc0), e1 = __expf(bc1);
            if (FULL) { *(LAS unsigned*)(lds + G_QD + t * GQ_STRIDE + dp * 4) = pk2(q0 * e0 * 0.08838834764831845f, q1 * e1 * 0.08838834764831845f);
                *(LAS unsigned*)(lds + G_KD + t * GQ_STRIDE + dp * 4) = pk2(k0 * __expf(-bc0), k1 * __expf(-bc1)); }
            const float o0 = k0 * __expf(tot0 - bc0), o1 = k1 * __expf(tot1 - bc1);
            if (i & 1) { ko0[i >> 1] = pk2(__uint_as_float(ko0[i >> 1]), o0); ko1[i >> 1] = pk2(__uint_as_float(ko1[i >> 1]), o1); }
            else { ko0[i >> 1] = __float_as_uint(o0); ko1[i >> 1] = __float_as_uint(o1); } }
        *(LAS u32x4*)(lds + G_KT + d0 * GT_STRIDE + w * 16) = (u32x4){ko0[0], ko0[1], ko0[2], ko0[3]};
        *(LAS u32x4*)(lds + G_KT + (d0 + 1) * GT_STRIDE + w * 16) = (u32x4){ko1[0], ko1[1], ko1[2], ko1[3]};
#pragma unroll
        for (int it = 0; it < 2; ++it) { const int unit = tid + NTHREADS * it, tp = unit & 31, dvb = unit >> 5;
            const u32x4 a = vraw[it][0], bq = vraw[it][1];
            LAS unsigned char* vb = lds + G_VT + (8 * dvb) * GT_STRIDE + tp * 4;
            *(LAS unsigned*)(vb + 0 * GT_STRIDE) = (a.x & 0xffffu) | (bq.x << 16); *(LAS unsigned*)(vb + 1 * GT_STRIDE) = (a.x >> 16) | (bq.x & 0xffff0000u);
            *(LAS unsigned*)(vb + 2 * GT_STRIDE) = (a.y & 0xffffu) | (bq.y << 16); *(LAS unsigned*)(vb + 3 * GT_STRIDE) = (a.y >> 16) | (bq.y & 0xffff0000u);
            *(LAS unsigned*)(vb + 4 * GT_STRIDE) = (a.z & 0xffffu) | (bq.z << 16); *(LAS unsigned*)(vb + 5 * GT_STRIDE) = (a.z >> 16) | (bq.z & 0xffff0000u);
            *(LAS unsigned*)(vb + 6 * GT_STRIDE) = (a.w & 0xffffu) | (bq.w << 16); *(LAS unsigned*)(vb + 7 * GT_STRIDE) = (a.w >> 16) | (bq.w & 0xffff0000u); }
        __syncthreads();
        if (FULL) {
        if (w < 3) { const int it = (w >= 1), jt = (w == 2);
            f32x16 a = zero16();
#pragma unroll
            for (int s = 0; s < 8; ++s) a = MFMA32(lds_b128(lds + G_KD + (32 * jt + r32) * GQ_STRIDE + (16 * s + 8 * hh) * 2), lds_b128(lds + G_QD + (32 * it + r32) * GQ_STRIDE + (16 * s + 8 * hh) * 2), a);
            const int i = 32 * it + r32;
#pragma unroll
            for (int q4 = 0; q4 < 4; ++q4) { float v[4];
#pragma unroll
                for (int e = 0; e < 4; ++e) { const int j = 32 * jt + 8 * q4 + 4 * hh + e; v[e] = (j <= i) ? a[4 * q4 + e] : 0.f; }
                *(LAS u32x2*)(lds + G_ATT + i * GT_STRIDE + (32 * jt + 8 * q4 + 4 * hh) * 2) = (u32x2){pk2(v[0], v[1]), pk2(v[2], v[3])}; } }
        else if (w == 3) {
#pragma unroll
            for (int q4 = 0; q4 < 4; ++q4) *(LAS u32x2*)(lds + G_ATT + r32 * GT_STRIDE + (32 + 8 * q4 + 4 * hh) * 2) = (u32x2){0u, 0u}; }
        __syncthreads();
        f32x16 oacc[2]; oacc[0] = zero16(); oacc[1] = zero16();
#pragma unroll
        for (int mt = 0; mt < 4; ++mt) {
            const bf16x8 s0 = pack_step<0>(S[mt]), s1 = pack_step<1>(S[mt]);
#pragma unroll
            for (int it = 0; it < 2; ++it) { LAS const unsigned char* qb = lds + G_QD + (32 * it + r32) * GQ_STRIDE + (32 * mt + 4 * hh) * 2;
                oacc[it] = MFMA32(s0, lds_2xb64(qb, qb + 16), oacc[it]);
                oacc[it] = MFMA32(s1, lds_2xb64(qb + 32, qb + 48), oacc[it]); } }
#pragma unroll
        for (int s = 0; s < 4; ++s) { const bf16x8 va = lds_b128(lds + G_VT + (32 * w + r32) * GT_STRIDE + (16 * s + 8 * hh) * 2);
#pragma unroll
            for (int it = 0; it < 2; ++it) oacc[it] = MFMA32(va, lds_b128(lds + G_ATT + (32 * it + r32) * GT_STRIDE + (16 * s + 8 * hh) * 2), oacc[it]); }
#pragma unroll
        for (int it = 0; it < 2; ++it)
#pragma unroll
            for (int q4 = 0; q4 < 4; ++q4)
                *(LAS u32x2*)(lds + G_OST + (32 * it + r32) * GO_STRIDE + (32 * w + 8 * q4 + 4 * hh) * 2) = (u32x2){pk2(oacc[it][4 * q4], oacc[it][4 * q4 + 1]), pk2(oacc[it][4 * q4 + 2], oacc[it][4 * q4 + 3])};
        }
#pragma unroll
        for (int mt = 0; mt < 4; ++mt) {
#pragma unroll
            for (int q4 = 0; q4 < 4; ++q4) { const f32x4 dv4 = *(LAS const f32x4*)(dvec + 32 * mt + 8 * q4 + 4 * hh);
                S[mt][4 * q4] *= dv4.x; S[mt][4 * q4 + 1] *= dv4.y; S[mt][4 * q4 + 2] *= dv4.z; S[mt][4 * q4 + 3] *= dv4.w; }
#pragma unroll
            for (int s = 0; s < 4; ++s) S[mt] = MFMA32(lds_b128(lds + G_KT + (32 * mt + r32) * GT_STRIDE + (16 * s + 8 * hh) * 2), lds_b128(lds + G_VT + (32 * w + r32) * GT_STRIDE + (16 * s + 8 * hh) * 2), S[mt]); }
        __syncthreads();
        if (FULL) {
        { const int i = tid >> 3, part = tid & 7; float ov[4][8]; float ss = 0.f;
#pragma unroll
          for (int q = 0; q < 4; ++q) { const u32x4 rv = *(LAS const u32x4*)(lds + G_OST + i * GO_STRIDE + (8 * q + part) * 16);
              ov[q][0] = bflo(rv.x); ov[q][1] = bfhi(rv.x); ov[q][2] = bflo(rv.y); ov[q][3] = bfhi(rv.y); ov[q][4] = bflo(rv.z); ov[q][5] = bfhi(rv.z); ov[q][6] = bflo(rv.w); ov[q][7] = bfhi(rv.w);
#pragma unroll
              for (int e = 0; e < 8; ++e) ss += ov[q][e] * ov[q][e]; }
          ss += __shfl_xor(ss, 1); ss += __shfl_xor(ss, 2); ss += __shfl_xor(ss, 4);
          const float rs = rsqrtf(ss * (1.f / 256.f) + EPS);
          if (i < T) { const size_t hrow = rowb + i;
#pragma unroll
              for (int q = 0; q < 4; ++q) { const int cq = 8 * q + part; float gv[8]; load8_h(H + hrow * LDH + C_GG + hd * 256 + cq * 8, gv);
                  const f32x4 n0 = *(const f32x4*)(P.gng + cq * 8), n1 = *(const f32x4*)(P.gng + cq * 8 + 4);
                  u32x4 o; o.x = pk2(ov[q][0] * rs * n0.x * silu(gv[0]), ov[q][1] * rs * n0.y * silu(gv[1])); o.y = pk2(ov[q][2] * rs * n0.z * silu(gv[2]), ov[q][3] * rs * n0.w * silu(gv[3]));
                  o.z = pk2(ov[q][4] * rs * n1.x * silu(gv[4]), ov[q][5] * rs * n1.y * silu(gv[5])); o.w = pk2(ov[q][6] * rs * n1.z * silu(gv[6]), ov[q][7] * rs * n1.w * silu(gv[7]));
                  *(u32x4*)(MIX + hrow * DM + 1024 + hd * 256 + cq * 8) = o; } } }
            }
    }
    if (!FULL || sample || grp == 7) {
        float* so = (!FULL ? LBUF + ((size_t)item * 128) * 256 : P.out + (sample ? O_GS : O_GP) + ((size_t)bh * 128) * 256) + 32 * w + r32;
#pragma unroll
        for (int mt = 0; mt < 4; ++mt)
#pragma unroll
            for (int e = 0; e < 16; ++e) so[(size_t)(32 * mt + 8 * (e >> 2) + 4 * hh + (e & 3)) * 256] = S[mt][e];
        if (!FULL && w == 0) { DBUF[(size_t)item * 128 + d0] = __expf(gt0); DBUF[(size_t)item * 128 + d0 + 1] = __expf(gt1); }
    }
    __syncthreads();
}
__global__ void __launch_bounds__(NTHREADS, 2) hymba_fwd(Params P) {
    extern __shared__ __attribute__((aligned(16))) unsigned char smem[];
    LAS unsigned char* lds = (LAS unsigned char*)smem;
    cg::grid_group grid = cg::this_grid();
    const int tid = threadIdx.x, G = gridDim.x, blk = blockIdx.x;
    bf16* WG = (bf16*)(P.ws + WS_WG); bf16* WO = (bf16*)(P.ws + WS_WO); bf16* XB = (bf16*)(P.ws + WS_XB); bf16* MIX = (bf16*)(P.ws + WS_MIX); bf16* H = (bf16*)(P.ws + WS_H);

    p0_prologue(P, lds, tid);
    grid.sync();

    { pg8::Gemm g{XB, WG, MT, LDH, DM}; pg8::StaticOrder S; S.init(MT, LDH, G, blk);
      pg8::EpiH E{H, LDH};
      pg8::gemm_phase<pg8::EpiH, pg8::StaticOrder, true, true>(lds, g, S, E); }
    grid.sync();

#pragma unroll 1
    for (int ph = 0; ph < 2; ++ph) {
        if (ph == 0) win_items(P, tid);
#pragma unroll 1
        for (int v = blk; v < 256; v += G) { const int grp = v >> 5, bh = v & 31;
            const int nfull = (ph == 0) ? ((grp == 7) ? 2 : 0) : 1;
#pragma unroll 1
            for (int k = 0; k < nfull; ++k) gla_run<true>(P, lds, tid, ph == 0 ? 2 : 1, ph == 0 ? 2 * bh + k : bh * 8 + grp);
            if (ph == 0 && grp < 7) gla_run<false>(P, lds, tid, 0, bh * 8 + grp); }
        int ub, us, ue;
        if (ph == 0) { const int A0 = (G >= 64) ? 32 : G, ib = blk - (G - A0); ub = (ib >= 0) ? ib : 96; us = A0; ue = 96; } else { ub = 96 + blk; us = G; ue = 2048 + 64; }
#pragma unroll 1
        for (int u = ub; u < ue; u += us) { att_unit(P, lds, tid, u); __syncthreads(); }
        grid.sync();
    }

    { pg8::Gemm g{MIX, WO, MT, DM, DM}; pg8::StaticOrder S; S.init(MT, DM, G, blk);
      pg8::EpiRes E{P.x_p, P.x_s, P.out, MP / 256};
      pg8::gemm_phase<pg8::EpiRes, pg8::StaticOrder, true, true>(lds, g, S, E); }
}

extern "C" void kernel_launch(void* const* d_in, const int* in_sizes, int n_in, void* d_out, int out_size, void* d_ws, size_t ws_size, hipStream_t stream) {
    static int grid_blocks = 0;
    if (grid_blocks == 0) {
        if (n_in != 14 || (size_t)out_size != O_END || ws_size < WS_END) { fprintf(stderr, "kernel_launch: unexpected shapes: n_in %d out %d ws %zu (need %zu)\n", n_in, out_size, ws_size, (size_t)WS_END); grid_blocks = -1; return; }
        int dev = 0, cus = 0, per_cu = 0;
        hipGetDevice(&dev);
        hipDeviceGetAttribute(&cus, hipDeviceAttributeMultiprocessorCount, dev);
        if (hipFuncSetAttribute((const void*)hymba_fwd, hipFuncAttributeMaxDynamicSharedMemorySize, LDS_BYTES) != hipSuccess) { fprintf(stderr, "kernel_launch: hipFuncSetAttribute failed\n"); grid_blocks = -1; return; }
        if (hipOccupancyMaxActiveBlocksPerMultiprocessor(&per_cu, (const void*)hymba_fwd, NTHREADS, LDS_BYTES) != hipSuccess || per_cu < 1) { fprintf(stderr, "kernel_launch: occupancy query says %d blocks per CU\n", per_cu); per_cu = 1; }
        (void)hipGetLastError();
        grid_blocks = cus;
        fprintf(stderr, "kernel_launch: %d CUs, %d blocks/CU by the occupancy query, grid %d\n", cus, per_cu, grid_blocks);
    }
    if (grid_blocks < 0) return;
    Params p{};
    p.x_p = (const float*)d_in[0]; p.x_s = (const float*)d_in[1]; p.cache_k = (const float*)d_in[2]; p.cache_v = (const float*)d_in[3]; p.state = (const float*)d_in[4];
    p.norm_g = (const float*)d_in[5]; p.w_in = (const float*)d_in[6]; p.w_gu = (const float*)d_in[7]; p.b_gate = (const float*)d_in[8]; p.qng = (const float*)d_in[9];
    p.kng = (const float*)d_in[10]; p.sinks = (const float*)d_in[11]; p.gng = (const float*)d_in[12]; p.w_out = (const float*)d_in[13];
    p.out = (float*)d_out; p.ws = (unsigned char*)d_ws;
    void* args[] = {&p};
    hipError_t e = hipLaunchCooperativeKernel((const void*)hymba_fwd, dim3(grid_blocks), dim3(NTHREADS), args, LDS_BYTES, stream);
    if (e != hipSuccess) fprintf(stderr, "kernel_launch: cooperative launch failed: %s (grid %d)\n", hipGetErrorString(e), grid_blocks);
}
```

```cpp
#include <hip/hip_runtime.h>
#include <hip/hip_cooperative_groups.h>
#include <cstdio>
#include <cstdint>
namespace cg = cooperative_groups;
namespace pg8 {
#define PG8_LAS __attribute__((address_space(3)))
typedef unsigned short bf16_t;
typedef short bf16x8 __attribute__((ext_vector_type(8)));
typedef float f32x4 __attribute__((ext_vector_type(4)));
typedef unsigned u32x4 __attribute__((ext_vector_type(4)));
constexpr int BM = 256, BK = 64, HALF = 128, HTB = HALF * BK * 2  , STAGE_BYTES = 8 * HTB, NXCD = 8, WGM = 8;

__host__ __device__ __forceinline__ int lds_byte(int r, int c) { const int st = (r >> 4) * 2 + (c >> 5), rr = r & 15, cc = c & 31, ob = rr * 64 + cc * 2; return st * 1024 + (ob ^ (((ob >> 9) & 1) << 5)); }
__host__ __device__ __forceinline__ void stage_rc(int b, int& R, int& C) { const int st = b / 1024, sb = b % 1024, swz = sb ^ (((sb >> 9) & 1) << 5); R = (st >> 1) * 16 + swz / 64; C = (st & 1) * 32 + (swz % 64) / 2; }
__host__ __device__ __forceinline__ int perm32(int rho) { const int n = rho >> 4, i = rho & 15; return 8 * (i >> 2) + 4 * n + (i & 3); }

struct Unit { int pm, pn; };
struct Gemm { const bf16_t* A; const bf16_t* Bt; int M, N, K; };

struct StaticOrder {
    int nM, nN, nwg, G, c;
    __host__ __device__ void init(int M, int N, int G_, int c_) { nM = M / BM; nN = N / BM; nwg = nM * nN; G = G_; c = c_; }
    __host__ __device__ bool next(int i, Unit& u) const {
        const long L = (long)i * G + c; if (L >= nwg) return false;
        int wgid = (int)L; { const int q = nwg / NXCD, r = nwg % NXCD, xcd = wgid % NXCD, off = wgid / NXCD; wgid = (xcd < r ? xcd * (q + 1) : r * (q + 1) + (xcd - r) * q) + off; }
        const int nig = WGM * nN, gid = wgid / nig, fm = gid * WGM, gsz = (nM - fm) < WGM ? (nM - fm) : WGM;
        u.pm = fm + ((wgid % nig) % gsz); u.pn = (wgid % nig) / gsz; return true;
    }
    __device__ __forceinline__ void a_ready(const Unit&) const {}
    __device__ __forceinline__ void done(const Unit&) const {}
};

__device__ __forceinline__ unsigned cvt_pk_bf16(float lo, float hi) { unsigned r; asm volatile("v_cvt_pk_bf16_f32 %0, %1, %2" : "=v"(r) : "v"(lo), "v"(hi)); return r; }
struct EpiH {
    static constexpr bool PERM = true, AFTER_DRAIN = false;
    bf16_t* O; int ldc;
    __device__ __forceinline__ void operator()(const f32x4 (&acc)[2][2][4][2], const Unit& u, int wr, int wc, int fr, int fq) const {
        const int row0 = u.pm * BM + wr * 64 + fr, col0 = u.pn * BM + wc * 32 + 8 * fq;
#pragma unroll
        for (int ai = 0; ai < 2; ++ai)
#pragma unroll
            for (int m = 0; m < 4; ++m) { bf16_t* rowp = O + (size_t)(row0 + ai * HALF + m * 16) * ldc + col0;
#pragma unroll
                for (int bj = 0; bj < 2; ++bj) { const f32x4 v0 = acc[ai][bj][m][0], v1 = acc[ai][bj][m][1];
                    u32x4 w; w.x = cvt_pk_bf16(v0[0], v0[1]); w.y = cvt_pk_bf16(v0[2], v0[3]); w.z = cvt_pk_bf16(v1[0], v1[1]); w.w = cvt_pk_bf16(v1[2], v1[3]);
                    *(u32x4*)(rowp + bj * HALF) = w; } }
    }
};
struct EpiRes {
    static constexpr bool PERM = false, AFTER_DRAIN = false;
    const float* xa; const float* xb; float* C; int split_pm;
    __device__ __forceinline__ void operator()(const f32x4 (&acc)[2][2][4][2], const Unit& u, int wr, int wc, int fr, int fq) const {
        const int lrow0 = wr * 64 + fr, col0 = u.pn * BM + wc * 32 + 4 * fq;
        const float* xt = (u.pm < split_pm) ? xa + (size_t)u.pm * BM * 2048 : xb + (size_t)(u.pm - split_pm) * BM * 2048;
        float* ct = C + (size_t)u.pm * BM * 2048;
#pragma unroll
        for (int ai = 0; ai < 2; ++ai)
#pragma unroll
            for (int m = 0; m < 4; ++m) { const size_t off = (size_t)(lrow0 + ai * HALF + m * 16) * 2048 + col0;
#pragma unroll
                for (int bj = 0; bj < 2; ++bj)
#pragma unroll
                    for (int n = 0; n < 2; ++n) *(f32x4*)(ct + off + bj * HALF + n * 16) = acc[ai][bj][m][n] + *(const f32x4*)(xt + off + bj * HALF + n * 16); }
    }
};
template <class Epi, class Sched, bool ALIGN_EPI = false, bool SP2 = false>
__device__ __forceinline__ void gemm_phase(PG8_LAS unsigned char* lds, const Gemm g, const Sched& S, const Epi& E) {
    int tid_ = threadIdx.x; asm volatile("" : "+v"(tid_));
    const int tid = tid_, wid = __builtin_amdgcn_readfirstlane(tid >> 6), lane = tid & 63, wr = wid >> 2, wc = wid & 3, fr = lane & 15, fq = lane >> 4;
    const int K = g.K, nt = K / BK;
    unsigned voffA[2], voffB[2];
#pragma unroll
    for (int i = 0; i < 2; ++i) { int R, C; stage_rc(tid * 16 + i * 8192, R, C); const int Rb = Epi::PERM ? ((R & ~31) + perm32(R & 31)) : R;
        voffA[i] = (unsigned)(R * K + C) * 2u; voffB[i] = (unsigned)(Rb * K + C) * 2u; }
    const size_t kstep = (size_t)(BK * 2);
    const size_t hstep = (size_t)HALF * K * 2;
    const size_t tstep = 2 * hstep;
    const unsigned ldsw = (unsigned)wid * 1024u;
    const int aoff = lds_byte(wr * 64 + fr, fq * 8), boff = lds_byte(wc * 32 + fr, fq * 8);
#define PG8_SA(b, h) (((b) * 2 + (h)) * HTB)
#define PG8_SB(b, h) ((4 + (b) * 2 + (h)) * HTB)
#define PG8_STAGE(bufoff, gbase, voff) do { _Pragma("unroll") for (int _i = 0; _i < 2; ++_i) \
        __builtin_amdgcn_global_load_lds((const unsigned*)((const char*)(gbase) + (voff)[_i]), (PG8_LAS unsigned*)(lds + (bufoff) + ldsw + _i * 8192), 16, 0, 0); } while (0)
#define PG8_LDA(dst, b, h) do { _Pragma("unroll") for (int m = 0; m < 4; ++m) _Pragma("unroll") for (int k = 0; k < 2; ++k) dst[m][k] = *(const PG8_LAS bf16x8*)(lds + PG8_SA(b, h) + aoff + m * 2048 + k * 1024); } while (0)
#define PG8_LDB(dst, b, h) do { _Pragma("unroll") for (int n = 0; n < 2; ++n) _Pragma("unroll") for (int k = 0; k < 2; ++k) dst[n][k] = *(const PG8_LAS bf16x8*)(lds + PG8_SB(b, h) + boff + n * 2048 + k * 1024); } while (0)
#define PG8_MMA(ai, bj, At, Bt) do { __builtin_amdgcn_s_setprio(1); _Pragma("unroll") for (int m = 0; m < 4; ++m) _Pragma("unroll") for (int n = 0; n < 2; ++n) _Pragma("unroll") for (int k = 0; k < 2; ++k) \
        acc[ai][bj][m][n] = __builtin_amdgcn_mfma_f32_16x16x32_bf16(Bt[n][k], At[m][k], acc[ai][bj][m][n], 0, 0, 0); __builtin_amdgcn_s_setprio(0); } while (0)
#define PG8_WAIT_V(n) asm volatile("s_waitcnt vmcnt(" #n ")" ::: "memory")
#define PG8_WAIT_L(n) asm volatile("s_waitcnt lgkmcnt(" #n ")" ::: "memory")
#define PG8_BAR __builtin_amdgcn_s_barrier()
#define PG8_SCHED __builtin_amdgcn_sched_barrier(0)
    Unit cur, nxt; int ui = 0;
    if (!S.next(0, cur)) return;
    f32x4 acc[2][2][4][2];
#pragma unroll
    for (int a = 0; a < 2; ++a)
#pragma unroll
        for (int b = 0; b < 2; ++b)
#pragma unroll
            for (int m = 0; m < 4; ++m)
#pragma unroll
                for (int n = 0; n < 2; ++n) acc[a][b][m][n] = (f32x4){0.f, 0.f, 0.f, 0.f};
    bf16x8 At[4][2], B0[2][2], B1[2][2];
    const char* cA = (const char*)g.A + (size_t)cur.pm * tstep; const char* cB = (const char*)g.Bt + (size_t)cur.pn * tstep;
    S.a_ready(cur);
    if constexpr (SP2) {
        PG8_STAGE(PG8_SB(0, 0), cB, voffB); PG8_STAGE(PG8_SB(0, 1), cB + hstep, voffB); PG8_STAGE(PG8_SA(0, 0), cA, voffA); PG8_STAGE(PG8_SA(0, 1), cA + hstep, voffA);
        if (wr == 1) PG8_BAR;
        PG8_WAIT_V(2); PG8_BAR;
        PG8_STAGE(PG8_SB(1, 0), cB + kstep, voffB); PG8_STAGE(PG8_SA(1, 0), cA + kstep, voffA); PG8_STAGE(PG8_SB(1, 1), cB + hstep + kstep, voffB);
        PG8_WAIT_V(6); PG8_BAR;
    } else {
        PG8_STAGE(PG8_SB(0, 0), cB, voffB); PG8_STAGE(PG8_SA(0, 0), cA, voffA); PG8_STAGE(PG8_SB(0, 1), cB + hstep, voffB); PG8_STAGE(PG8_SA(0, 1), cA + hstep, voffA);
        if (wr == 1) PG8_BAR;
        PG8_WAIT_V(4); PG8_BAR;
        PG8_STAGE(PG8_SB(1, 0), cB + kstep, voffB); PG8_STAGE(PG8_SA(1, 0), cA + kstep, voffA); PG8_STAGE(PG8_SB(1, 1), cB + hstep + kstep, voffB);
        PG8_WAIT_V(6); PG8_BAR;
    }
    for (;;) {
        const bool has_next = S.next(ui + 1, nxt);
        const char* nA = has_next ? (const char*)g.A + (size_t)nxt.pm * tstep : cA; const char* nB = has_next ? (const char*)g.Bt + (size_t)nxt.pn * tstep : cB;
        for (int t = 0; t < nt; t += 2) {
            const bool last = (t == nt - 2);
            const char* a1 = cA + (size_t)(t + 1) * kstep;
            const char* a2 = last ? nA : cA + (size_t)(t + 2) * kstep; const char* b2 = last ? nB : cB + (size_t)(t + 2) * kstep;
            const char* a3 = a2 + kstep; const char* b3 = b2 + kstep;
            if (last && has_next) S.a_ready(nxt);
            if constexpr (SP2) {
            PG8_LDB(B0, 0, 0); PG8_LDB(B1, 0, 1); PG8_SCHED; PG8_LDA(At, 0, 0); PG8_STAGE(PG8_SA(1, 1), a1 + hstep, voffA);
            PG8_WAIT_V(8); PG8_WAIT_L(0); PG8_BAR; PG8_MMA(0, 0, At, B0); PG8_MMA(0, 1, At, B1); PG8_BAR; PG8_SCHED;
            PG8_LDA(At, 0, 1); PG8_STAGE(PG8_SB(0, 0), b2, voffB); PG8_STAGE(PG8_SB(0, 1), b2 + hstep, voffB); PG8_STAGE(PG8_SA(0, 0), a2, voffA);
            PG8_WAIT_V(8); PG8_WAIT_L(0); PG8_BAR; PG8_MMA(1, 0, At, B0); PG8_MMA(1, 1, At, B1); PG8_BAR; PG8_SCHED;
            PG8_LDB(B0, 1, 0); PG8_LDB(B1, 1, 1); PG8_SCHED; PG8_LDA(At, 1, 0); PG8_STAGE(PG8_SA(0, 1), a2 + hstep, voffA);
            PG8_WAIT_V(8); PG8_WAIT_L(0); PG8_BAR; PG8_MMA(0, 0, At, B0); PG8_MMA(0, 1, At, B1); PG8_BAR; PG8_SCHED;
            PG8_LDA(At, 1, 1); PG8_STAGE(PG8_SB(1, 0), b3, voffB); PG8_STAGE(PG8_SB(1, 1), b3 + hstep, voffB); PG8_STAGE(PG8_SA(1, 0), a3, voffA);
            PG8_WAIT_V(8); PG8_WAIT_L(0); PG8_BAR; PG8_MMA(1, 0, At, B0); PG8_MMA(1, 1, At, B1); PG8_BAR; PG8_SCHED;
            } else {
            PG8_LDB(B0, 0, 0); PG8_SCHED; PG8_LDA(At, 0, 0); PG8_STAGE(PG8_SA(1, 1), a1 + hstep, voffA);
            PG8_WAIT_L(8); PG8_BAR; PG8_WAIT_L(0); PG8_MMA(0, 0, At, B0); PG8_BAR; PG8_SCHED;
            PG8_LDB(B1, 0, 1); PG8_STAGE(PG8_SB(0, 0), b2, voffB);
            PG8_BAR; PG8_WAIT_L(0); PG8_MMA(0, 1, At, B1); PG8_BAR;
            PG8_LDA(At, 0, 1); PG8_STAGE(PG8_SA(0, 0), a2, voffA);
            PG8_BAR; PG8_WAIT_L(0); PG8_MMA(1, 0, At, B0); PG8_BAR; PG8_SCHED;
            PG8_STAGE(PG8_SB(0, 1), b2 + hstep, voffB);
            PG8_WAIT_V(6); PG8_BAR; PG8_MMA(1, 1, At, B1); PG8_BAR;
            PG8_LDB(B0, 1, 0); PG8_SCHED; PG8_LDA(At, 1, 0); PG8_STAGE(PG8_SA(0, 1), a2 + hstep, voffA);
            PG8_WAIT_L(8); PG8_BAR; PG8_WAIT_L(0); PG8_MMA(0, 0, At, B0); PG8_BAR; PG8_SCHED;
            PG8_LDB(B1, 1, 1); PG8_STAGE(PG8_SB(1, 0), b3, voffB);
            PG8_BAR; PG8_WAIT_L(0); PG8_MMA(0, 1, At, B1); PG8_BAR;
            PG8_LDA(At, 1, 1); PG8_STAGE(PG8_SA(1, 0), a3, voffA);
            PG8_BAR; PG8_WAIT_L(0); PG8_MMA(1, 0, At, B0); PG8_BAR; PG8_SCHED;
            PG8_STAGE(PG8_SB(1, 1), b3 + hstep, voffB);
            PG8_WAIT_V(6); PG8_BAR; PG8_MMA(1, 1, At, B1); PG8_BAR;
            }
        }
        if constexpr (ALIGN_EPI) { if (wr == 0) PG8_BAR; }
        if constexpr (!Epi::AFTER_DRAIN) { E(acc, cur, wr, wc, fr, fq); S.done(cur); }
        if (!has_next) break;
#pragma unroll
        for (int a = 0; a < 2; ++a)
#pragma unroll
            for (int b = 0; b < 2; ++b)
#pragma unroll
                for (int m = 0; m < 4; ++m)
#pragma unroll
                    for (int n = 0; n < 2; ++n) acc[a][b][m][n] = (f32x4){0.f, 0.f, 0.f, 0.f};
        cur = nxt; cA = nA; cB = nB; ++ui;
        if constexpr (ALIGN_EPI) { if (wr == 1) PG8_BAR; }
    }
    PG8_WAIT_V(0);
    if constexpr (!ALIGN_EPI) { if (wr == 0) PG8_BAR; }
    PG8_BAR;
    if constexpr (Epi::AFTER_DRAIN) { E.fused(acc, cur, wr, wc, fr, fq, lds, wid, lane); S.done(cur); }
#undef PG8_SA
#undef PG8_SB
#undef PG8_STAGE
#undef PG8_LDA
#undef PG8_LDB
#undef PG8_MMA
#undef PG8_WAIT_V
#undef PG8_WAIT_L
#undef PG8_BAR
#undef PG8_SCHED
}
}
#define LAS __attribute__((address_space(3)))
#define DI __device__ __forceinline__
typedef unsigned short bf16;
typedef short bf16x8 __attribute__((ext_vector_type(8)));
typedef float f32x4 __attribute__((ext_vector_type(4)));
typedef float f32x16 __attribute__((ext_vector_type(16)));
typedef unsigned u32x4 __attribute__((ext_vector_type(4)));
typedef unsigned u32x2 __attribute__((ext_vector_type(2)));
typedef float f32x2_t __attribute__((ext_vector_type(2)));
typedef __bf16 bf16x2_t __attribute__((ext_vector_type(2)));

constexpr int DM = 2048, NB = 8, SEQL = 4096, DECB = 16, DECS = 16;
constexpr int MP = NB * SEQL, MS = DECB * DECS, MT = MP + MS;
constexpr int NIN = 5648, LDH = 5888;
constexpr int C_QA = 0, C_KA = 1024, C_VA = 1280, C_GA = 1536, C_QG = 2560, C_KG = 3072, C_VG = 3584, C_GG = 4608, C_LR = 5632;
constexpr float EPS = 1e-6f;
constexpr size_t MiB = 1u << 20;
constexpr size_t WS_WG = 0, WS_WO = 24 * MiB, WS_XB = 32 * MiB, WS_MIX = 161 * MiB, WS_H = 290 * MiB, WS_L = 662 * MiB, WS_D = 694 * MiB, WS_KT = 695 * MiB, WS_DV = 728 * MiB, WS_END = 730 * MiB;
static_assert(WS_H + (size_t)MT * LDH * 2 <= WS_L && (size_t)LDH * DM * 2 <= WS_WO && WS_XB + (size_t)MT * DM * 2 <= WS_MIX && WS_MIX + (size_t)MT * DM * 2 <= WS_H, "ws map");
constexpr size_t O_YP = 0, O_YS = (size_t)MP * DM, O_WKP = O_YS + (size_t)MS * DM, O_WVP = O_WKP + 262144, O_GP = O_WVP + 262144,
                 O_WKS = O_GP + 1048576, O_WVS = O_WKS + 524288, O_GS = O_WVS + 524288, O_END = O_GS + 2097152;
constexpr int LDS_BYTES = 155648;
constexpr int NTHREADS = 512;

struct Params {
    const float *x_p, *x_s, *cache_k, *cache_v, *state, *norm_g, *w_in, *w_gu, *b_gate, *qng, *kng, *sinks, *gng, *w_out;
    float* out; unsigned char* ws;
};

DI unsigned pk2(float lo, float hi) { f32x2_t v = {lo, hi}; bf16x2_t b = __builtin_convertvector(v, bf16x2_t); return __builtin_bit_cast(unsigned, b); }
DI float bflo(unsigned u) { return __uint_as_float(u << 16); }
DI float bfhi(unsigned u) { return __uint_as_float(u & 0xffff0000u); }
DI float wave_sum(float v) {
#pragma unroll
    for (int o = 1; o < 64; o <<= 1) v += __shfl_xor(v, o);
    return v;
}
DI float silu(float x) { return x / (1.f + __expf(-x)); }
#define BAR_LDS() do { asm volatile("s_waitcnt lgkmcnt(0)" ::: "memory"); __builtin_amdgcn_s_barrier(); asm volatile("" ::: "memory"); } while (0)
#define MFMA32(a, b, c) __builtin_amdgcn_mfma_f32_32x32x16_bf16((a), (b), (c), 0, 0, 0)
DI f32x16 zero16() { f32x16 z;
#pragma unroll
    for (int i = 0; i < 16; ++i) z[i] = 0.f;
    return z; }
template <int S> DI bf16x8 pack_step(const f32x16& x) {
    u32x4 p; p.x = pk2(x[8 * S + 0], x[8 * S + 1]); p.y = pk2(x[8 * S + 2], x[8 * S + 3]); p.z = pk2(x[8 * S + 4], x[8 * S + 5]); p.w = pk2(x[8 * S + 6], x[8 * S + 7]);
    return __builtin_bit_cast(bf16x8, p);
}
DI bf16x8 lds_b128(LAS const unsigned char* p) { return *(LAS const bf16x8*)p; }
DI bf16x8 lds_2xb64(LAS const unsigned char* p0, LAS const unsigned char* p1) {
    const u32x2 a = *(LAS const u32x2*)p0, b = *(LAS const u32x2*)p1; u32x4 r; r.x = a.x; r.y = a.y; r.z = b.x; r.w = b.y; return __builtin_bit_cast(bf16x8, r);
}

DI void p0_transpose_item(const float* W, const float* rs, int K, int N, bf16* WT, LAS float* scr, int item, int lane) {
    const int nblk = (N + 31) / 32, kb = item / nblk, nb = item % nblk, k0 = 64 * kb, n0 = 32 * nb;
#pragma unroll 8
    for (int i = 0; i < 32; ++i) { const int kk = 2 * i + (lane >> 5), n = n0 + (lane & 31);
        float v = (n < N) ? W[(size_t)(k0 + kk) * N + n] : 0.f; if (rs) v *= rs[k0 + kk];
        scr[kk * 33 + (lane & 31)] = v; }
    asm volatile("s_waitcnt lgkmcnt(0)" ::: "memory");
    const int c = lane & 7;
#pragma unroll
    for (int j = 0; j < 4; ++j) { const int n = (lane >> 3) + 8 * j; LAS const float* s = scr + (8 * c) * 33 + n;
        u32x4 o; o.x = pk2(s[0 * 33], s[1 * 33]); o.y = pk2(s[2 * 33], s[3 * 33]); o.z = pk2(s[4 * 33], s[5 * 33]); o.w = pk2(s[6 * 33], s[7 * 33]);
        *(u32x4*)(WT + (size_t)(n0 + n) * K + k0 + 8 * c) = o; }
    asm volatile("s_waitcnt lgkmcnt(0)" ::: "memory");
}
DI void p0_prologue(const Params& P, LAS unsigned char* lds, int tid) {
    const int lane = tid & 63, wave = tid >> 6, G = gridDim.x;
    const int gw = blockIdx.x * 8 + wave, NGW = G * 8;
    LAS float* scr = (LAS float*)(lds + wave * 16384);
    bf16* WG = (bf16*)(P.ws + WS_WG); bf16* WO = (bf16*)(P.ws + WS_WO); bf16* XB = (bf16*)(P.ws + WS_XB);
    constexpr int I_IN = (DM / 64) * ((NIN + 31) / 32), I_OUT = (DM / 64) * (DM / 32);
    for (int it = gw; it < I_IN + I_OUT; it += NGW) {
        if (it < I_IN) p0_transpose_item(P.w_in, P.norm_g, DM, NIN, WG, scr, it, lane);
        else p0_transpose_item(P.w_out, nullptr, DM, DM, WO, scr, it - I_IN, lane);
    }
    { const size_t n16 = (size_t)(LDH - 5664) * DM * 2 / 16; u32x4* z = (u32x4*)(WG + (size_t)5664 * DM);
      for (size_t i = (size_t)blockIdx.x * NTHREADS + tid; i < n16; i += (size_t)G * NTHREADS) z[i] = (u32x4){0u, 0u, 0u, 0u}; }
    for (int r = gw; r < MT; r += NGW) {
        const float* src = (r < MP) ? P.x_p + (size_t)r * DM : P.x_s + (size_t)(r - MP) * DM;
        const f32x4* xr = (const f32x4*)src + lane;
        f32x4 v[8]; float s = 0.f;
#pragma unroll
        for (int j = 0; j < 8; ++j) { v[j] = xr[64 * j]; s += (v[j].x * v[j].x + v[j].y * v[j].y) + (v[j].z * v[j].z + v[j].w * v[j].w); }
        const float rstd = rsqrtf(wave_sum(s) * (1.f / DM) + EPS);
        u32x2* o8 = (u32x2*)(XB + (size_t)r * DM) + lane;
#pragma unroll
        for (int j = 0; j < 8; ++j) { u32x2 w; w.x = pk2(v[j].x * rstd, v[j].y * rstd); w.y = pk2(v[j].z * rstd, v[j].w * rstd); o8[64 * j] = w; }
    }
}
DI void load8_h(const bf16* p, float (&v)[8]) { const u32x4 r = *(const u32x4*)p; v[0] = bflo(r.x); v[1] = bfhi(r.x); v[2] = bflo(r.y); v[3] = bfhi(r.y); v[4] = bflo(r.z); v[5] = bfhi(r.z); v[6] = bflo(r.w); v[7] = bfhi(r.w); }
DI void load8_f(const float* p, float (&v)[8]) { const f32x4 a = *(const f32x4*)p, b = *(const f32x4*)(p + 4); v[0] = a.x; v[1] = a.y; v[2] = a.z; v[3] = a.w; v[4] = b.x; v[5] = b.y; v[6] = b.z; v[7] = b.w; }
DI void store8_f(float* p, const float (&v)[8]) { *(f32x4*)p = (f32x4){v[0], v[1], v[2], v[3]}; *(f32x4*)(p + 4) = (f32x4){v[4], v[5], v[6], v[7]}; }
DI void norm8(float (&v)[8], const float* g, int part, float extra) {
    float ss = 0.f;
#pragma unroll
    for (int i = 0; i < 8; ++i) ss += v[i] * v[i];
    ss += __shfl_xor(ss, 1); ss += __shfl_xor(ss, 2); ss += __shfl_xor(ss, 4);
    const float rs = rsqrtf(ss * (1.f / 64.f) + EPS) * extra;
    const f32x4 g0 = *(const f32x4*)(g + part * 8), g1 = *(const f32x4*)(g + part * 8 + 4);
    v[0] *= rs * g0.x; v[1] *= rs * g0.y; v[2] *= rs * g0.z; v[3] *= rs * g0.w; v[4] *= rs * g1.x; v[5] *= rs * g1.y; v[6] *= rs * g1.z; v[7] *= rs * g1.w;
}
DI void win_items(const Params& P, int tid) {
    const bf16* H = (const bf16*)(P.ws + WS_H);
    const int ngrp = 4096 + 8192;
    for (int gt = blockIdx.x * NTHREADS + tid; gt < ((ngrp * 8 + 63) & ~63); gt += gridDim.x * NTHREADS) {
        int grp = gt >> 3; const int part = gt & 7; const bool act = grp < ngrp; if (!act) grp = 0;
        float kv[8], vv[8]; float* ok; float* ov; bool do_norm = true;
        if (grp < 4096) { const int b = grp >> 9, j = (grp >> 2) & 127, g = grp & 3; const size_t hrow = (size_t)b * SEQL + (SEQL - 128) + j;
            load8_h(H + hrow * LDH + C_KA + g * 64 + part * 8, kv); load8_h(H + hrow * LDH + C_VA + g * 64 + part * 8, vv);
            const size_t o = ((size_t)(b * 128 + j) * 4 + g) * 64 + part * 8; ok = P.out + O_WKP + o; ov = P.out + O_WVP + o; }
        else { const int s = grp - 4096, b = s >> 9, j = (s >> 2) & 127, g = s & 3;
            const size_t o = ((size_t)(b * 128 + j) * 4 + g) * 64 + part * 8; ok = P.out + O_WKS + o; ov = P.out + O_WVS + o;
            if (j < 112) { const size_t ci = ((size_t)(b * 128 + j + 16) * 4 + g) * 64 + part * 8; load8_f(P.cache_k + ci, kv); load8_f(P.cache_v + ci, vv); do_norm = false; }
            else { const size_t hrow = (size_t)MP + b * DECS + (j - 112);
                load8_h(H + hrow * LDH + C_KA + g * 64 + part * 8, kv); load8_h(H + hrow * LDH + C_VA + g * 64 + part * 8, vv); } }
        float kn[8];
#pragma unroll
        for (int i = 0; i < 8; ++i) kn[i] = kv[i];
        norm8(kn, P.kng, part, 1.f);
        if (do_norm) {
#pragma unroll
            for (int i = 0; i < 8; ++i) kv[i] = kn[i]; }
        if (act) { store8_f(ok, kv); store8_f(ov, vv); }
    }
}

constexpr int AK_STRIDE = 144, AV_STRIDE = 400, AO_STRIDE = 144;
constexpr int A_K_OFF = 0, A_V_OFF = 192 * AK_STRIDE  , A_O_OFF = A_V_OFF + 64 * AV_STRIDE  , A_END = A_O_OFF + 8 * 32 * AO_STRIDE  ;
static_assert(A_END <= LDS_BYTES, "attention LDS");
DI void att_unit(const Params& P, LAS unsigned char* lds, int tid, int u) {
    asm volatile("" : "+v"(tid));
    const bf16* H = (const bf16*)(P.ws + WS_H); bf16* MIX = (bf16*)(P.ws + WS_MIX);
    const int lane = tid & 63, w = tid >> 6, r32 = lane & 31, hh = lane >> 5;
    const bool sample = u >= 2048;
    int b, c, g; if (!sample) { b = u >> 8; c = (u >> 2) & 63; g = u & 3; } else { const int v = u - 2048; b = v >> 2; c = 0; g = v & 3; }
    const int j_lo = sample ? 0 : ((c >= 2) ? 0 : (2 - c) * 64), j_hi = sample ? 144 : 192;
    const size_t krow0 = sample ? (size_t)MP + b * DECS - 128 : (size_t)b * SEQL + (size_t)(c - 2) * 64;
#pragma unroll
    for (int i = 0; i < 3; ++i) { const int p = tid + NTHREADS * i, key = p >> 3, part = p & 7;
        const bool valid = key >= j_lo && key < j_hi, cached = sample && key < 128;
        float kv[8];
#pragma unroll
        for (int e = 0; e < 8; ++e) kv[e] = 0.f;
        if (valid) { if (cached) load8_f(P.cache_k + ((size_t)(b * 128 + key) * 4 + g) * 64 + part * 8, kv); else load8_h(H + (krow0 + key) * LDH + C_KA + g * 64 + part * 8, kv); }
        float kn[8];
#pragma unroll
        for (int e = 0; e < 8; ++e) kn[e] = kv[e];
        norm8(kn, P.kng, part, 1.f);
        if (!cached) {
#pragma unroll
            for (int e = 0; e < 8; ++e) kv[e] = kn[e]; }
        u32x4 o; o.x = pk2(kv[0], kv[1]); o.y = pk2(kv[2], kv[3]); o.z = pk2(kv[4], kv[5]); o.w = pk2(kv[6], kv[7]);
        *(LAS u32x4*)(lds + A_K_OFF + key * AK_STRIDE + part * 16) = o; }
#pragma unroll
    for (int it = 0; it < 2; ++it) { const int q = tid + NTHREADS * it;
        if (q < 768) { const int kp = q % 96, part = q / 96; float v0[8], v1[8];
#pragma unroll
            for (int e = 0; e < 8; ++e) { v0[e] = 0.f; v1[e] = 0.f; }
            const int k0 = 2 * kp, k1 = 2 * kp + 1;
            if (k0 >= j_lo && k0 < j_hi) { if (sample && k0 < 128) load8_f(P.cache_v + ((size_t)(b * 128 + k0) * 4 + g) * 64 + part * 8, v0); else load8_h(H + (krow0 + k0) * LDH + C_VA + g * 64 + part * 8, v0); }
            if (k1 >= j_lo && k1 < j_hi) { if (sample && k1 < 128) load8_f(P.cache_v + ((size_t)(b * 128 + k1) * 4 + g) * 64 + part * 8, v1); else load8_h(H + (krow0 + k1) * LDH + C_VA + g * 64 + part * 8, v1); }
#pragma unroll
            for (int e = 0; e < 8; ++e) *(LAS unsigned*)(lds + A_V_OFF + (8 * part + e) * AV_STRIDE + kp * 4) = pk2(v0[e], v1[e]); } }
    const int r = w >> 1, th = w & 1, tl = 32 * th + r32, hq = g * 4 + r;
    const bool qvalid = sample ? (tl < DECS) : true;
    const size_t qrow = sample ? (size_t)MP + b * DECS + (qvalid ? tl : 0) : (size_t)b * SEQL + (size_t)c * 64 + tl;
    bf16x8 qf[4];
    { float qv[4][8]; float ss = 0.f;
#pragma unroll
      for (int s = 0; s < 4; ++s) { load8_h(H + qrow * LDH + C_QA + hq * 64 + 16 * s + 8 * hh, qv[s]);
#pragma unroll
          for (int e = 0; e < 8; ++e) ss += qv[s][e] * qv[s][e]; }
      ss += __shfl_xor(ss, 32);
      const float rs = rsqrtf(ss * (1.f / 64.f) + EPS) * 0.125f;
#pragma unroll
      for (int s = 0; s < 4; ++s) { const f32x4 g0 = *(const f32x4*)(P.qng + 16 * s + 8 * hh), g1 = *(const f32x4*)(P.qng + 16 * s + 8 * hh + 4);
          u32x4 o; o.x = pk2(qv[s][0] * rs * g0.x, qv[s][1] * rs * g0.y); o.y = pk2(qv[s][2] * rs * g0.z, qv[s][3] * rs * g0.w);
          o.z = pk2(qv[s][4] * rs * g1.x, qv[s][5] * rs * g1.y); o.w = pk2(qv[s][6] * rs * g1.z, qv[s][7] * rs * g1.w); qf[s] = __builtin_bit_cast(bf16x8, o); } }
    const float sink = P.sinks[hq];
    __syncthreads();
    f32x16 oacc[2]; oacc[0] = zero16(); oacc[1] = zero16();
    float m = sink, l = 0.f;
#pragma unroll
    for (int t = 0; t < 6; ++t) {
        if (32 * t + 32 > j_lo && 32 * t < j_hi) {
            f32x16 a = zero16();
#pragma unroll
            for (int s = 0; s < 4; ++s) a = MFMA32(lds_b128(lds + A_K_OFF + (32 * t + r32) * AK_STRIDE + (16 * s + 8 * hh) * 2), qf[s], a);
            float tm = -INFINITY;
#pragma unroll
            for (int e = 0; e < 16; ++e) { const int key = 32 * t + 8 * (e >> 2) + 4 * hh + (e & 3); const bool ok = key >= j_lo && key < j_hi;
                a[e] = ok ? a[e] : -INFINITY; tm = fmaxf(tm, a[e]); }
            tm = fmaxf(tm, __shfl_xor(tm, 32));
            const float mn = fmaxf(m, tm), sc = __expf(m - mn); m = mn;
            float ls = 0.f;
#pragma unroll
            for (int e = 0; e < 16; ++e) { const float p = __expf(a[e] - m); a[e] = p; ls += p; }
            l = l * sc + ls;
#pragma unroll
            for (int e = 0; e < 16; ++e) { oacc[0][e] *= sc; oacc[1][e] *= sc; }
            const bf16x8 p0 = pack_step<0>(a), p1 = pack_step<1>(a);
#pragma unroll
            for (int dt = 0; dt < 2; ++dt) {
                LAS const unsigned char* vb = lds + A_V_OFF + (32 * dt + r32) * AV_STRIDE + (32 * t + 4 * hh) * 2;
                oacc[dt] = MFMA32(lds_2xb64(vb, vb + 16), p0, oacc[dt]);
                oacc[dt] = MFMA32(lds_2xb64(vb + 32, vb + 48), p1, oacc[dt]);
            }
        }
    }
    l += __shfl_xor(l, 32);
    l += __expf(sink - m);
    const float inv_l = 1.f / l;
    LAS unsigned char* ost = lds + A_O_OFF + w * 32 * AO_STRIDE;
#pragma unroll
    for (int dt = 0; dt < 2; ++dt)
#pragma unroll
        for (int q4 = 0; q4 < 4; ++q4) { u32x2 o; o.x = pk2(oacc[dt][4 * q4] * inv_l, oacc[dt][4 * q4 + 1] * inv_l); o.y = pk2(oacc[dt][4 * q4 + 2] * inv_l, oacc[dt][4 * q4 + 3] * inv_l);
            *(LAS u32x2*)(ost + r32 * AO_STRIDE + (32 * dt + 8 * q4 + 4 * hh) * 2) = o; }
    __syncthreads();
#pragma unroll
    for (int it = 0; it < 4; ++it) { const int row = (lane >> 3) + 8 * it, part = lane & 7, t2 = 32 * th + row;
        const bool ok = sample ? (t2 < DECS) : true;
        if (ok) { const size_t hrow = sample ? (size_t)MP + b * DECS + t2 : (size_t)b * SEQL + (size_t)c * 64 + t2;
            const u32x4 ov = *(LAS const u32x4*)(ost + row * AO_STRIDE + part * 16);
            float gv[8]; load8_h(H + hrow * LDH + C_GA + hq * 64 + part * 8, gv);
            u32x4 o; o.x = pk2(bflo(ov.x) * silu(gv[0]), bfhi(ov.x) * silu(gv[1])); o.y = pk2(bflo(ov.y) * silu(gv[2]), bfhi(ov.y) * silu(gv[3]));
            o.z = pk2(bflo(ov.z) * silu(gv[4]), bfhi(ov.z) * silu(gv[5])); o.w = pk2(bflo(ov.w) * silu(gv[6]), bfhi(ov.w) * silu(gv[7]));
            *(u32x4*)(MIX + hrow * DM + hq * 64 + part * 8) = o; } }
}
DI void att_loop(const Params& P, LAS unsigned char* lds, int tid, int begin, int step, int end) {
    asm volatile("" : "+v"(tid));
    const bf16* H = (const bf16*)(P.ws + WS_H); bf16* MIX = (bf16*)(P.ws + WS_MIX);
    const int lane = tid & 63, w = tid >> 6, r32 = lane & 31, hh = lane >> 5;
    const int r = w >> 1, th = w & 1, tl = 32 * th + r32;
    u32x4 kraw[3], vraw[2][2], qraw[4];
#define ATT_ISSUE(U) do { const int b_ = (U) >> 8, c_ = ((U) >> 2) & 63, g_ = (U) & 3; const int jlo_ = (c_ >= 2) ? 0 : (2 - c_) * 64; \
        const size_t krow0_ = (size_t)b_ * SEQL + (size_t)(c_ - 2) * 64; \
        _Pragma("unroll") for (int i_ = 0; i_ < 3; ++i_) { const int p_ = tid + NTHREADS * i_, key_ = p_ >> 3, part_ = p_ & 7; kraw[i_] = (u32x4){0u, 0u, 0u, 0u}; \
            if (key_ >= jlo_) kraw[i_] = *(const u32x4*)(H + (krow0_ + key_) * LDH + C_KA + g_ * 64 + part_ * 8); } \
        _Pragma("unroll") for (int it_ = 0; it_ < 2; ++it_) { const int q_ = tid + NTHREADS * it_, kp_ = q_ % 96, part_ = q_ / 96; \
            vraw[it_][0] = (u32x4){0u, 0u, 0u, 0u}; vraw[it_][1] = (u32x4){0u, 0u, 0u, 0u}; \
            if (q_ < 768 && 2 * kp_ >= jlo_) { vraw[it_][0] = *(const u32x4*)(H + (krow0_ + 2 * kp_) * LDH + C_VA + g_ * 64 + part_ * 8); \
                vraw[it_][1] = *(const u32x4*)(H + (krow0_ + 2 * kp_ + 1) * LDH + C_VA + g_ * 64 + part_ * 8); } } \
        { const size_t qrow_ = (size_t)b_ * SEQL + (size_t)c_ * 64 + tl; \
          _Pragma("unroll") for (int s_ = 0; s_ < 4; ++s_) qraw[s_] = *(const u32x4*)(H + qrow_ * LDH + C_QA + (g_ * 4 + r) * 64 + 16 * s_ + 8 * hh); } } while (0)
    if (begin < end) ATT_ISSUE(begin);
    for (int u = begin; u < end; u += step) {
        const int b = u >> 8, c = (u >> 2) & 63, g = u & 3, hq = g * 4 + r;
        const int j_lo = (c >= 2) ? 0 : (2 - c) * 64; constexpr int j_hi = 192;
#pragma unroll
        for (int i = 0; i < 3; ++i) { const int p = tid + NTHREADS * i, key = p >> 3, part = p & 7;
            float kv[8]; { const u32x4 rw = kraw[i]; kv[0] = bflo(rw.x); kv[1] = bfhi(rw.x); kv[2] = bflo(rw.y); kv[3] = bfhi(rw.y); kv[4] = bflo(rw.z); kv[5] = bfhi(rw.z); kv[6] = bflo(rw.w); kv[7] = bfhi(rw.w); }
            norm8(kv, P.kng, part, 1.f);
            u32x4 o; o.x = pk2(kv[0], kv[1]); o.y = pk2(kv[2], kv[3]); o.z = pk2(kv[4], kv[5]); o.w = pk2(kv[6], kv[7]);
            *(LAS u32x4*)(lds + A_K_OFF + key * AK_STRIDE + part * 16) = o; }
#pragma unroll
        for (int it = 0; it < 2; ++it) { const int q = tid + NTHREADS * it;
            if (q < 768) { const int kp = q % 96, part = q / 96; const u32x4 a = vraw[it][0], bq = vraw[it][1];
                LAS unsigned char* vb = lds + A_V_OFF + (8 * part) * AV_STRIDE + kp * 4;
                *(LAS unsigned*)(vb + 0 * AV_STRIDE) = (a.x & 0xffffu) | (bq.x << 16); *(LAS unsigned*)(vb + 1 * AV_STRIDE) = (a.x >> 16) | (bq.x & 0xffff0000u);
                *(LAS unsigned*)(vb + 2 * AV_STRIDE) = (a.y & 0xffffu) | (bq.y << 16); *(LAS unsigned*)(vb + 3 * AV_STRIDE) = (a.y >> 16) | (bq.y & 0xffff0000u);
                *(LAS unsigned*)(vb + 4 * AV_STRIDE) = (a.z & 0xffffu) | (bq.z << 16); *(LAS unsigned*)(vb + 5 * AV_STRIDE) = (a.z >> 16) | (bq.z & 0xffff0000u);
                *(LAS unsigned*)(vb + 6 * AV_STRIDE) = (a.w & 0xffffu) | (bq.w << 16); *(LAS unsigned*)(vb + 7 * AV_STRIDE) = (a.w >> 16) | (bq.w & 0xffff0000u); } }
        bf16x8 qf[4];
        { float qv[4][8]; float ss = 0.f;
#pragma unroll
          for (int s = 0; s < 4; ++s) { const u32x4 rw = qraw[s]; qv[s][0] = bflo(rw.x); qv[s][1] = bfhi(rw.x); qv[s][2] = bflo(rw.y); qv[s][3] = bfhi(rw.y); qv[s][4] = bflo(rw.z); qv[s][5] = bfhi(rw.z); qv[s][6] = bflo(rw.w); qv[s][7] = bfhi(rw.w);
#pragma unroll
              for (int e = 0; e < 8; ++e) ss += qv[s][e] * qv[s][e]; }
          ss += __shfl_xor(ss, 32);
          const float rs = rsqrtf(ss * (1.f / 64.f) + EPS) * 0.125f;
#pragma unroll
          for (int s = 0; s < 4; ++s) { const f32x4 g0 = *(const f32x4*)(P.qng + 16 * s + 8 * hh), g1 = *(const f32x4*)(P.qng + 16 * s + 8 * hh + 4);
              u32x4 o; o.x = pk2(qv[s][0] * rs * g0.x, qv[s][1] * rs * g0.y); o.y = pk2(qv[s][2] * rs * g0.z, qv[s][3] * rs * g0.w);
              o.z = pk2(qv[s][4] * rs * g1.x, qv[s][5] * rs * g1.y); o.w = pk2(qv[s][6] * rs * g1.z, qv[s][7] * rs * g1.w); qf[s] = __builtin_bit_cast(bf16x8, o); } }
        const float sink = P.sinks[hq];
        u32x4 garaw[4];
#pragma unroll
        for (int it = 0; it < 4; ++it) { const int row = (lane >> 3) + 8 * it, part = lane & 7; const size_t hrow = (size_t)b * SEQL + (size_t)c * 64 + 32 * th + row;
            garaw[it] = *(const u32x4*)(H + hrow * LDH + C_GA + hq * 64 + part * 8); }
        if (u + step < end) ATT_ISSUE(u + step);
        BAR_LDS();
        f32x16 oacc[2]; oacc[0] = zero16(); oacc[1] = zero16();
        float m = sink, l = 0.f;
#pragma unroll
        for (int t = 0; t < 6; ++t) {
            if (32 * t + 32 > j_lo) {
                f32x16 a = zero16();
#pragma unroll
                for (int s = 0; s < 4; ++s) a = MFMA32(lds_b128(lds + A_K_OFF + (32 * t + r32) * AK_STRIDE + (16 * s + 8 * hh) * 2), qf[s], a);
                float tm = -INFINITY;
#pragma unroll
                for (int e = 0; e < 16; ++e) { const int key = 32 * t + 8 * (e >> 2) + 4 * hh + (e & 3); const bool ok = key >= j_lo && key < j_hi;
                    a[e] = ok ? a[e] : -INFINITY; tm = fmaxf(tm, a[e]); }
                tm = fmaxf(tm, __shfl_xor(tm, 32));
                const float mn = fmaxf(m, tm), sc = __expf(m - mn); m = mn;
                float ls = 0.f;
#pragma unroll
                for (int e = 0; e < 16; ++e) { const float p = __expf(a[e] - m); a[e] = p; ls += p; }
                l = l * sc + ls;
#pragma unroll
                for (int e = 0; e < 16; ++e) { oacc[0][e] *= sc; oacc[1][e] *= sc; }
                const bf16x8 p0 = pack_step<0>(a), p1 = pack_step<1>(a);
#pragma unroll
                for (int dt = 0; dt < 2; ++dt) {
                    LAS const unsigned char* vb = lds + A_V_OFF + (32 * dt + r32) * AV_STRIDE + (32 * t + 4 * hh) * 2;
                    oacc[dt] = MFMA32(lds_2xb64(vb, vb + 16), p0, oacc[dt]);
                    oacc[dt] = MFMA32(lds_2xb64(vb + 32, vb + 48), p1, oacc[dt]);
                }
            }
        }
        l += __shfl_xor(l, 32);
        l += __expf(sink - m);
        const float inv_l = 1.f / l;
        LAS unsigned char* ost = lds + A_O_OFF + w * 32 * AO_STRIDE;
#pragma unroll
        for (int dt = 0; dt < 2; ++dt)
#pragma unroll
            for (int q4 = 0; q4 < 4; ++q4) { u32x2 o; o.x = pk2(oacc[dt][4 * q4] * inv_l, oacc[dt][4 * q4 + 1] * inv_l); o.y = pk2(oacc[dt][4 * q4 + 2] * inv_l, oacc[dt][4 * q4 + 3] * inv_l);
                *(LAS u32x2*)(ost + r32 * AO_STRIDE + (32 * dt + 8 * q4 + 4 * hh) * 2) = o; }
        BAR_LDS();
#pragma unroll
        for (int it = 0; it < 4; ++it) { const int row = (lane >> 3) + 8 * it, part = lane & 7; const size_t hrow = (size_t)b * SEQL + (size_t)c * 64 + 32 * th + row;
            const u32x4 ov = *(LAS const u32x4*)(ost + row * AO_STRIDE + part * 16); const u32x4 gr = garaw[it];
            u32x4 o; o.x = pk2(bflo(ov.x) * silu(bflo(gr.x)), bfhi(ov.x) * silu(bfhi(gr.x))); o.y = pk2(bflo(ov.y) * silu(bflo(gr.y)), bfhi(ov.y) * silu(bfhi(gr.y)));
            o.z = pk2(bflo(ov.z) * silu(bflo(gr.z)), bfhi(ov.z) * silu(bfhi(gr.z))); o.w = pk2(bflo(ov.w) * silu(bflo(gr.w)), bfhi(ov.w) * silu(bfhi(gr.w)));
            *(u32x4*)(MIX + hrow * DM + hq * 64 + part * 8) = o; }
    }
#undef ATT_ISSUE
    __syncthreads();
}
constexpr int GQ_STRIDE = 272, GT_STRIDE = 144, GO_STRIDE = 528;
constexpr int G_QD = 0, G_KD = G_QD + 64 * GQ_STRIDE  , G_KT = G_KD + 64 * GQ_STRIDE  , G_VT = G_KT + 128 * GT_STRIDE  ,
              G_ATT = G_VT + 256 * GT_STRIDE  , G_OST = G_ATT + 64 * GT_STRIDE  , G_SEG = G_OST + 64 * GO_STRIDE  , G_DV = G_SEG + 8 * 128 * 4  ,
              G_LR = G_DV + 512  , G_GN = G_LR + 4096  , G_WG = G_GN + 1024  , G_END = G_WG + 8192;
static_assert(G_END <= LDS_BYTES, "GLA LDS");
struct GlaItem { int sample, grp, bh, b, hd, c_begin, nchunks, T, cid0; size_t row0; };
DI GlaItem gla_item(int item) {
    GlaItem g; g.sample = item >= 256; g.grp = g.sample ? 0 : (item & 7); g.bh = g.sample ? item - 256 : (item >> 3); g.b = g.bh >> 2; g.hd = g.bh & 3;
    g.c_begin = g.sample ? 0 : 8 * g.grp; g.nchunks = g.sample ? 1 : 8; g.T = g.sample ? DECS : 64;
    g.row0 = g.sample ? (size_t)MP + g.b * DECS : (size_t)g.b * SEQL;
    g.cid0 = g.sample ? 2048 + g.bh : (g.b * 64) * 4 + g.hd;
    return g;
}
DI void gla_put_vt(LAS unsigned char* lds, int tid, const u32x4 (&vraw)[2][2]) {
#pragma unroll
    for (int it = 0; it < 2; ++it) { const int unit = tid + NTHREADS * it, tp = unit & 31, dvb = unit >> 5;
        const u32x4 a = vraw[it][0], bq = vraw[it][1];
        LAS unsigned char* vb = lds + G_VT + (8 * dvb) * GT_STRIDE + tp * 4;
        *(LAS unsigned*)(vb + 0 * GT_STRIDE) = (a.x & 0xffffu) | (bq.x << 16); *(LAS unsigned*)(vb + 1 * GT_STRIDE) = (a.x >> 16) | (bq.x & 0xffff0000u);
        *(LAS unsigned*)(vb + 2 * GT_STRIDE) = (a.y & 0xffffu) | (bq.y << 16); *(LAS unsigned*)(vb + 3 * GT_STRIDE) = (a.y >> 16) | (bq.y & 0xffff0000u);
        *(LAS unsigned*)(vb + 4 * GT_STRIDE) = (a.z & 0xffffu) | (bq.z << 16); *(LAS unsigned*)(vb + 5 * GT_STRIDE) = (a.z >> 16) | (bq.z & 0xffff0000u);
        *(LAS unsigned*)(vb + 6 * GT_STRIDE) = (a.w & 0xffffu) | (bq.w << 16); *(LAS unsigned*)(vb + 7 * GT_STRIDE) = (a.w >> 16) | (bq.w & 0xffff0000u); }
}
#define GLA_ISSUE_V(CH) do { const size_t rb_ = g.row0 + (size_t)(CH) * 64; \
        _Pragma("unroll") for (int it_ = 0; it_ < 2; ++it_) { const int un_ = tid + NTHREADS * it_, tp_ = un_ & 31, dvb_ = un_ >> 5; \
            _Pragma("unroll") for (int k_ = 0; k_ < 2; ++k_) { const int t_ = 2 * tp_ + k_; vraw[it_][k_] = (u32x4){0u, 0u, 0u, 0u}; \
                if (t_ < g.T) vraw[it_][k_] = *(const u32x4*)(H + (rb_ + t_) * LDH + C_VG + g.hd * 256 + 8 * dvb_); } } } while (0)
DI void gla_state_update(LAS unsigned char* lds, f32x16 (&S)[4], int w, int r32, int hh) {
    LAS const float* dvec = (LAS const float*)(lds + G_DV);
#pragma unroll
    for (int mt = 0; mt < 4; ++mt) {
#pragma unroll
        for (int q4 = 0; q4 < 4; ++q4) { const f32x4 dv4 = *(LAS const f32x4*)(dvec + 32 * mt + 8 * q4 + 4 * hh);
            S[mt][4 * q4] *= dv4.x; S[mt][4 * q4 + 1] *= dv4.y; S[mt][4 * q4 + 2] *= dv4.z; S[mt][4 * q4 + 3] *= dv4.w; }
#pragma unroll
        for (int s = 0; s < 4; ++s) S[mt] = MFMA32(lds_b128(lds + G_KT + (32 * mt + r32) * GT_STRIDE + (16 * s + 8 * hh) * 2), lds_b128(lds + G_VT + (32 * w + r32) * GT_STRIDE + (16 * s + 8 * hh) * 2), S[mt]); }
}

DI void gla_prep(const Params& P, LAS unsigned char* lds, int tid, int item) {
    asm volatile("" : "+v"(tid));
    bf16* H = (bf16*)(P.ws + WS_H); bf16* KT = (bf16*)(P.ws + WS_KT); float* DVB = (float*)(P.ws + WS_DV);
    float* LBUF = (float*)(P.ws + WS_L); float* DBUF = (float*)(P.ws + WS_D);
    const int lane = tid & 63, w = tid >> 6, r32 = lane & 31, hh = lane >> 5;
    const GlaItem g = gla_item(item);
    const bool need_state = !g.sample && g.grp < 7;
    const int dp = lane, d0 = 2 * dp;
    for (int i = tid; i < 16 * 32; i += NTHREADS) { const int r = i >> 5, c4 = i & 31; *(LAS f32x4*)(lds + G_WG + r * 512 + c4 * 16) = *(const f32x4*)(P.w_gu + (size_t)r * 512 + g.hd * 128 + c4 * 4); }
    const f32x2_t bg = *(const f32x2_t*)(P.b_gate + g.hd * 128 + d0);
    f32x16 S[4];
#pragma unroll
    for (int mt = 0; mt < 4; ++mt) S[mt] = zero16();
    float gt0 = 0.f, gt1 = 0.f;
    LAS float* seg = (LAS float*)(lds + G_SEG); LAS float* dvec = (LAS float*)(lds + G_DV);
    u32x4 lrp = (u32x4){0u, 0u, 0u, 0u}; unsigned qraw[8], kraw[8];
#define GLA_ISSUE(CH) do { const size_t rb_ = g.row0 + (size_t)(CH) * 64; \
        lrp = (u32x4){0u, 0u, 0u, 0u}; if (tid < 128 && (tid >> 1) < g.T) lrp = *(const u32x4*)(H + (rb_ + (tid >> 1)) * LDH + C_LR + (tid & 1) * 8); \
        _Pragma("unroll") for (int i_ = 0; i_ < 8; ++i_) { const int t_ = 8 * w + i_; qraw[i_] = 0u; kraw[i_] = 0u; \
            if (t_ < g.T) { const bf16* hr_ = H + (rb_ + t_) * LDH; qraw[i_] = *(const unsigned*)(hr_ + C_QG + g.hd * 128 + d0); kraw[i_] = *(const unsigned*)(hr_ + C_KG + g.hd * 128 + d0); } } } while (0)
#define GLA_PUT_LR() do { if (tid < 128) { LAS float* d_ = (LAS float*)(lds + G_LR) + (tid >> 1) * 16 + (tid & 1) * 8; \
        *(LAS f32x4*)d_ = (f32x4){bflo(lrp.x), bfhi(lrp.x), bflo(lrp.y), bfhi(lrp.y)}; *(LAS f32x4*)(d_ + 4) = (f32x4){bflo(lrp.z), bfhi(lrp.z), bflo(lrp.w), bfhi(lrp.w)}; } } while (0)
    GLA_ISSUE(g.c_begin);
    GLA_PUT_LR();
    __syncthreads();
    for (int c = g.c_begin; c < g.c_begin + g.nchunks; ++c) {
        const size_t rowb = g.row0 + (size_t)c * 64; const int cid = g.cid0 + 4 * c;
        u32x4 vraw[2][2];
        if (need_state) GLA_ISSUE_V(c);
        float cs0[8], cs1[8];
        float run0 = 0.f, run1 = 0.f;
        { f32x2_t wgv[16];
#pragma unroll
          for (int r = 0; r < 16; ++r) wgv[r] = *(LAS const f32x2_t*)(lds + G_WG + r * 512 + d0 * 4);
#pragma unroll
          for (int i = 0; i < 8; ++i) { const int t = 8 * w + i;
            LAS const f32x4* lp = (LAS const f32x4*)(lds + G_LR + t * 64);
            f32x2_t z = bg;
#pragma unroll
            for (int r4 = 0; r4 < 4; ++r4) { const f32x4 l4 = lp[r4];
                z += wgv[4 * r4] * (f32x2_t){l4.x, l4.x}; z += wgv[4 * r4 + 1] * (f32x2_t){l4.y, l4.y}; z += wgv[4 * r4 + 2] * (f32x2_t){l4.z, l4.z}; z += wgv[4 * r4 + 3] * (f32x2_t){l4.w, l4.w}; }
            float la0 = (fminf(z.x, 0.f) - __logf(1.f + __expf(-fabsf(z.x)))) * (1.f / 16.f);
            float la1 = (fminf(z.y, 0.f) - __logf(1.f + __expf(-fabsf(z.y)))) * (1.f / 16.f);
            if (t >= g.T) { la0 = 0.f; la1 = 0.f; }
            run0 += la0; run1 += la1; cs0[i] = run0; cs1[i] = run1; } }
        *(LAS f32x2_t*)(seg + w * 128 + d0) = (f32x2_t){run0, run1};
        BAR_LDS();
        float pre0 = 0.f, pre1 = 0.f, tot0 = 0.f, tot1 = 0.f;
#pragma unroll
        for (int ww = 0; ww < 8; ++ww) { const f32x2_t sv = *(LAS const f32x2_t*)(seg + ww * 128 + d0); tot0 += sv.x; tot1 += sv.y; if (ww < w) { pre0 += sv.x; pre1 += sv.y; } }
        const float et0 = __expf(tot0), et1 = __expf(tot1);
        if (w == 0) *(LAS f32x2_t*)(dvec + d0) = (f32x2_t){et0, et1};
        gt0 += tot0; gt1 += tot1;
        unsigned ko0[4], ko1[4];
#pragma unroll
        for (int i = 0; i < 8; ++i) { const int t = 8 * w + i;
            const float bc0 = pre0 + cs0[i], bc1 = pre1 + cs1[i];
            const float q0 = bflo(qraw[i]), q1 = bfhi(qraw[i]), k0 = bflo(kraw[i]), k1 = bfhi(kraw[i]);
            const float e0 = __expf(bc0), e1 = __expf(bc1), r0 = __builtin_amdgcn_rcpf(e0), r1 = __builtin_amdgcn_rcpf(e1);
            *(LAS unsigned*)(lds + G_QD + t * GQ_STRIDE + dp * 4) = pk2(q0 * e0 * 0.08838834764831845f, q1 * e1 * 0.08838834764831845f);
            *(LAS unsigned*)(lds + G_KD + t * GQ_STRIDE + dp * 4) = pk2(k0 * r0, k1 * r1);
            const float o0 = k0 * (et0 * r0), o1 = k1 * (et1 * r1);
            if (i & 1) { ko0[i >> 1] = pk2(__uint_as_float(ko0[i >> 1]), o0); ko1[i >> 1] = pk2(__uint_as_float(ko1[i >> 1]), o1); }
            else { ko0[i >> 1] = __float_as_uint(o0); ko1[i >> 1] = __float_as_uint(o1); } }
        *(LAS u32x4*)(lds + G_KT + d0 * GT_STRIDE + w * 16) = (u32x4){ko0[0], ko0[1], ko0[2], ko0[3]};
        *(LAS u32x4*)(lds + G_KT + (d0 + 1) * GT_STRIDE + w * 16) = (u32x4){ko1[0], ko1[1], ko1[2], ko1[3]};
        if (need_state) gla_put_vt(lds, tid, vraw);
        const bool more = c + 1 < g.c_begin + g.nchunks;
        if (more) GLA_ISSUE(c + 1);
        BAR_LDS();
#pragma unroll
        for (int i = 0; i < 2; ++i) { const int p = tid + NTHREADS * i, fr = p >> 4, pc = p & 15;
            if (fr < g.T) { bf16* hr = H + (rowb + fr) * LDH + g.hd * 128 + pc * 8;
                *(u32x4*)(hr + C_QG) = *(LAS const u32x4*)(lds + G_QD + fr * GQ_STRIDE + pc * 16);
                *(u32x4*)(hr + C_KG) = *(LAS const u32x4*)(lds + G_KD + fr * GQ_STRIDE + pc * 16); }
            const int dk = p >> 3, p8 = p & 7;
            *(u32x4*)(KT + ((size_t)cid * 128 + dk) * 64 + p8 * 8) = *(LAS const u32x4*)(lds + G_KT + dk * GT_STRIDE + p8 * 16); }
        if (tid < 32) *(f32x4*)(DVB + (size_t)cid * 128 + tid * 4) = *(LAS const f32x4*)(dvec + tid * 4);
        if (need_state) gla_state_update(lds, S, w, r32, hh);
        if (more) GLA_PUT_LR();
        BAR_LDS();
    }
#undef GLA_ISSUE
#undef GLA_PUT_LR
    if (need_state) {
        float* so = LBUF + ((size_t)item * 128) * 256 + 32 * w + r32;
#pragma unroll
        for (int mt = 0; mt < 4; ++mt)
#pragma unroll
            for (int e = 0; e < 16; ++e) so[(size_t)(32 * mt + 8 * (e >> 2) + 4 * hh + (e & 3)) * 256] = S[mt][e];
        if (w == 0) *(f32x2_t*)(DBUF + (size_t)item * 128 + d0) = (f32x2_t){__expf(gt0), __expf(gt1)};
    }
}

DI void gla_scan(const Params& P, LAS unsigned char* lds, int tid, int item) {
    asm volatile("" : "+v"(tid));
    const bf16* H = (const bf16*)(P.ws + WS_H); bf16* MIX = (bf16*)(P.ws + WS_MIX); const bf16* KT = (const bf16*)(P.ws + WS_KT); const float* DVB = (const float*)(P.ws + WS_DV);
    const float* LBUF = (const float*)(P.ws + WS_L); const float* DBUF = (const float*)(P.ws + WS_D);
    const int lane = tid & 63, w = tid >> 6, r32 = lane & 31, hh = lane >> 5;
    const GlaItem g = gla_item(item);
    if (tid < 64) *(LAS f32x4*)(lds + G_GN + tid * 16) = *(const f32x4*)(P.gng + tid * 4);
    f32x16 S[4];
#pragma unroll
    for (int mt = 0; mt < 4; ++mt) S[mt] = zero16();
    if (g.sample) { const float* sp = P.state + ((size_t)g.bh * 128) * 256 + 32 * w + r32;
#pragma unroll
        for (int mt = 0; mt < 4; ++mt)
#pragma unroll
            for (int e = 0; e < 16; ++e) S[mt][e] = sp[(size_t)(32 * mt + 8 * (e >> 2) + 4 * hh + (e & 3)) * 256]; }
    else {
        for (int gp = 0; gp < g.grp; ++gp) { const float* lp = LBUF + ((size_t)(g.bh * 8 + gp) * 128) * 256 + 32 * w + r32; const float* dpv = DBUF + (size_t)(g.bh * 8 + gp) * 128;
#pragma unroll
            for (int mt = 0; mt < 4; ++mt)
#pragma unroll
                for (int q4 = 0; q4 < 4; ++q4) { const f32x4 d4 = *(const f32x4*)(dpv + 32 * mt + 8 * q4 + 4 * hh);
#pragma unroll
                    for (int e = 0; e < 4; ++e) S[mt][4 * q4 + e] = S[mt][4 * q4 + e] * d4[e] + lp[(size_t)(32 * mt + 8 * q4 + 4 * hh + e) * 256]; } } }
    u32x4 qdr[2], kdr[2], ktr[2], vraw[2][2]; f32x4 dvr = (f32x4){0.f, 0.f, 0.f, 0.f};
#define SCAN_ISSUE(CH) do { const size_t rb_ = g.row0 + (size_t)(CH) * 64; const int cid_ = g.cid0 + 4 * (CH); \
        _Pragma("unroll") for (int i_ = 0; i_ < 2; ++i_) { const int p_ = tid + NTHREADS * i_, fr_ = p_ >> 4, pc_ = p_ & 15; \
            qdr[i_] = (u32x4){0u, 0u, 0u, 0u}; kdr[i_] = (u32x4){0u, 0u, 0u, 0u}; \
            if (fr_ < g.T) { const bf16* hr_ = H + (rb_ + fr_) * LDH + g.hd * 128 + pc_ * 8; qdr[i_] = *(const u32x4*)(hr_ + C_QG); kdr[i_] = *(const u32x4*)(hr_ + C_KG); } \
            ktr[i_] = *(const u32x4*)(KT + ((size_t)cid_ * 128 + (p_ >> 3)) * 64 + (p_ & 7) * 8); } \
        if (tid < 32) dvr = *(const f32x4*)(DVB + (size_t)cid_ * 128 + tid * 4); \
        GLA_ISSUE_V(CH); } while (0)
    SCAN_ISSUE(g.c_begin);
    for (int c = g.c_begin; c < g.c_begin + g.nchunks; ++c) {
        const size_t rowb = g.row0 + (size_t)c * 64;
#pragma unroll
        for (int i = 0; i < 2; ++i) { const int p = tid + NTHREADS * i, fr = p >> 4, pc = p & 15;
            *(LAS u32x4*)(lds + G_QD + fr * GQ_STRIDE + pc * 16) = qdr[i]; *(LAS u32x4*)(lds + G_KD + fr * GQ_STRIDE + pc * 16) = kdr[i];
            *(LAS u32x4*)(lds + G_KT + (p >> 3) * GT_STRIDE + (p & 7) * 16) = ktr[i]; }
        if (tid < 32) *(LAS f32x4*)(lds + G_DV + tid * 16) = dvr;
        gla_put_vt(lds, tid, vraw);
        const bool more = c + 1 < g.c_begin + g.nchunks;
        if (more) SCAN_ISSUE(c + 1);
        BAR_LDS();
        if (w < 3) { const int it = (w >= 1), jt = (w == 2);
            f32x16 a = zero16();
#pragma unroll
            for (int s = 0; s < 8; ++s) a = MFMA32(lds_b128(lds + G_KD + (32 * jt + r32) * GQ_STRIDE + (16 * s + 8 * hh) * 2), lds_b128(lds + G_QD + (32 * it + r32) * GQ_STRIDE + (16 * s + 8 * hh) * 2), a);
            const int i = 32 * it + r32;
#pragma unroll
            for (int q4 = 0; q4 < 4; ++q4) { float v[4];
#pragma unroll
                for (int e = 0; e < 4; ++e) { const int j = 32 * jt + 8 * q4 + 4 * hh + e; v[e] = (j <= i) ? a[4 * q4 + e] : 0.f; }
                *(LAS u32x2*)(lds + G_ATT + i * GT_STRIDE + (32 * jt + 8 * q4 + 4 * hh) * 2) = (u32x2){pk2(v[0], v[1]), pk2(v[2], v[3])}; } }
        else if (w == 3) {
#pragma unroll
            for (int q4 = 0; q4 < 4; ++q4) *(LAS u32x2*)(lds + G_ATT + r32 * GT_STRIDE + (32 + 8 * q4 + 4 * hh) * 2) = (u32x2){0u, 0u}; }
        BAR_LDS();
#pragma unroll
        for (int it = 0; it < 2; ++it) { f32x16 oacc = zero16();
#pragma unroll
          for (int mt = 0; mt < 4; ++mt) {
            const bf16x8 s0 = pack_step<0>(S[mt]), s1 = pack_step<1>(S[mt]);
            LAS const unsigned char* qb = lds + G_QD + (32 * it + r32) * GQ_STRIDE + (32 * mt + 4 * hh) * 2;
            oacc = MFMA32(s0, lds_2xb64(qb, qb + 16), oacc);
            oacc = MFMA32(s1, lds_2xb64(qb + 32, qb + 48), oacc); }
#pragma unroll
          for (int s = 0; s < 4; ++s) oacc = MFMA32(lds_b128(lds + G_VT + (32 * w + r32) * GT_STRIDE + (16 * s + 8 * hh) * 2), lds_b128(lds + G_ATT + (32 * it + r32) * GT_STRIDE + (16 * s + 8 * hh) * 2), oacc);
#pragma unroll
          for (int q4 = 0; q4 < 4; ++q4)
            *(LAS u32x2*)(lds + G_OST + (32 * it + r32) * GO_STRIDE + (32 * w + 8 * q4 + 4 * hh) * 2) = (u32x2){pk2(oacc[4 * q4], oacc[4 * q4 + 1]), pk2(oacc[4 * q4 + 2], oacc[4 * q4 + 3])}; }
        gla_state_update(lds, S, w, r32, hh);
        u32x4 ggraw[4];
        { const int i = tid >> 3, part = tid & 7;
#pragma unroll
          for (int q = 0; q < 4; ++q) { ggraw[q] = (u32x4){0u, 0u, 0u, 0u}; if (i < g.T) ggraw[q] = *(const u32x4*)(H + (rowb + i) * LDH + C_GG + g.hd * 256 + (8 * q + part) * 8); } }
        BAR_LDS();
        { const int i = tid >> 3, part = tid & 7; float ov[4][8]; float ss = 0.f;
#pragma unroll
          for (int q = 0; q < 4; ++q) { const u32x4 rv = *(LAS const u32x4*)(lds + G_OST + i * GO_STRIDE + (8 * q + part) * 16);
              ov[q][0] = bflo(rv.x); ov[q][1] = bfhi(rv.x); ov[q][2] = bflo(rv.y); ov[q][3] = bfhi(rv.y); ov[q][4] = bflo(rv.z); ov[q][5] = bfhi(rv.z); ov[q][6] = bflo(rv.w); ov[q][7] = bfhi(rv.w);
#pragma unroll
              for (int e = 0; e < 8; ++e) ss += ov[q][e] * ov[q][e]; }
          ss += __shfl_xor(ss, 1); ss += __shfl_xor(ss, 2); ss += __shfl_xor(ss, 4);
          const float rs = rsqrtf(ss * (1.f / 256.f) + EPS);
          if (i < g.T) { const size_t hrow = rowb + i;
#pragma unroll
              for (int q = 0; q < 4; ++q) { const int cq = 8 * q + part; const u32x4 gr = ggraw[q];
                  const f32x4 n0 = *(LAS const f32x4*)(lds + G_GN + cq * 32), n1 = *(LAS const f32x4*)(lds + G_GN + cq * 32 + 16);
                  u32x4 o; o.x = pk2(ov[q][0] * rs * n0.x * silu(bflo(gr.x)), ov[q][1] * rs * n0.y * silu(bfhi(gr.x))); o.y = pk2(ov[q][2] * rs * n0.z * silu(bflo(gr.y)), ov[q][3] * rs * n0.w * silu(bfhi(gr.y)));
                  o.z = pk2(ov[q][4] * rs * n1.x * silu(bflo(gr.z)), ov[q][5] * rs * n1.y * silu(bfhi(gr.z))); o.w = pk2(ov[q][6] * rs * n1.z * silu(bflo(gr.w)), ov[q][7] * rs * n1.w * silu(bfhi(gr.w)));
                  *(u32x4*)(MIX + hrow * DM + 1024 + g.hd * 256 + cq * 8) = o; } } }
    }
#undef SCAN_ISSUE
    if (g.sample || g.grp == 7) {
        float* so = P.out + (g.sample ? O_GS : O_GP) + ((size_t)g.bh * 128) * 256 + 32 * w + r32;
#pragma unroll
        for (int mt = 0; mt < 4; ++mt)
#pragma unroll
            for (int e = 0; e < 16; ++e) so[(size_t)(32 * mt + 8 * (e >> 2) + 4 * hh + (e & 3)) * 256] = S[mt][e];
    }
    __syncthreads();
}
#undef GLA_ISSUE_V
__global__ void __launch_bounds__(NTHREADS, 2) hymba_fwd(Params P) {
    extern __shared__ __attribute__((aligned(16))) unsigned char smem[];
    LAS unsigned char* lds = (LAS unsigned char*)smem;
    cg::grid_group grid = cg::this_grid();
    const int tid = threadIdx.x, G = gridDim.x, blk = blockIdx.x;
    bf16* WG = (bf16*)(P.ws + WS_WG); bf16* WO = (bf16*)(P.ws + WS_WO); bf16* XB = (bf16*)(P.ws + WS_XB); bf16* MIX = (bf16*)(P.ws + WS_MIX); bf16* H = (bf16*)(P.ws + WS_H);

    p0_prologue(P, lds, tid);
    grid.sync();

    { pg8::Gemm g{XB, WG, MT, LDH, DM}; pg8::StaticOrder S; S.init(MT, LDH, G, blk);
      pg8::EpiH E{H, LDH};
      pg8::gemm_phase<pg8::EpiH, pg8::StaticOrder, true, true>(lds, g, S, E); }
    grid.sync();

    win_items(P, tid);
#pragma unroll 1
    for (int it = blk; it < 320; it += G) { gla_prep(P, lds, tid, (it < 256) ? ((it & 31) * 8 + (it >> 5)) : it); __syncthreads(); }
    grid.sync();
#pragma unroll 1
    for (int it = blk; it < 320; it += G) gla_scan(P, lds, tid, (it < 256) ? ((it & 31) * 8 + (it >> 5)) : it);
    att_loop(P, lds, tid, blk, G, 2048);
#pragma unroll 1
    for (int u = 2048 + blk; u < 2048 + 64; u += G) { att_unit(P, lds, tid, u); __syncthreads(); }
    grid.sync();

    { pg8::Gemm g{MIX, WO, MT, DM, DM}; pg8::StaticOrder S; S.init(MT, DM, G, blk);
      pg8::EpiRes E{P.x_p, P.x_s, P.out, MP / 256};
      pg8::gemm_phase<pg8::EpiRes, pg8::StaticOrder, true, true>(lds, g, S, E); }
}

extern "C" void kernel_launch(void* const* d_in, const int* in_sizes, int n_in, void* d_out, int out_size, void* d_ws, size_t ws_size, hipStream_t stream) {
    static int grid_blocks = 0;
    if (grid_blocks == 0) {
        if (n_in != 14 || (size_t)out_size != O_END || ws_size < WS_END) { fprintf(stderr, "kernel_launch: unexpected shapes: n_in %d out %d ws %zu (need %zu)\n", n_in, out_size, ws_size, (size_t)WS_END); grid_blocks = -1; return; }
        int dev = 0, cus = 0, per_cu = 0;
        hipGetDevice(&dev);
        hipDeviceGetAttribute(&cus, hipDeviceAttributeMultiprocessorCount, dev);
        if (hipFuncSetAttribute((const void*)hymba_fwd, hipFuncAttributeMaxDynamicSharedMemorySize, LDS_BYTES) != hipSuccess) { fprintf(stderr, "kernel_launch: hipFuncSetAttribute failed\n"); grid_blocks = -1; return; }
        if (hipOccupancyMaxActiveBlocksPerMultiprocessor(&per_cu, (const void*)hymba_fwd, NTHREADS, LDS_BYTES) != hipSuccess || per_cu < 1) { fprintf(stderr, "kernel_launch: occupancy query says %d blocks per CU\n", per_cu); per_cu = 1; }
        (void)hipGetLastError();
        grid_blocks = cus;
        fprintf(stderr, "kernel_launch: %d CUs, %d blocks/CU by the occupancy query, grid %d\n", cus, per_cu, grid_blocks);
    }
    if (grid_blocks < 0) return;
    Params p{};
    p.x_p = (const float*)d_in[0]; p.x_s = (const float*)d_in[1]; p.cache_k = (const float*)d_in[2]; p.cache_v = (const float*)d_in[3]; p.state = (const float*)d_in[4];
    p.norm_g = (const float*)d_in[5]; p.w_in = (const float*)d_in[6]; p.w_gu = (const float*)d_in[7]; p.b_gate = (const float*)d_in[8]; p.qng = (const float*)d_in[9];
    p.kng = (const float*)d_in[10]; p.sinks = (const float*)d_in[11]; p.gng = (const float*)d_in[12]; p.w_out = (const float*)d_in[13];
    p.out = (float*)d_out; p.ws = (unsigned char*)d_ws;
    void* args[] = {&p};
    hipError_t e = hipLaunchCooperativeKernel((const void*)hymba_fwd, dim3(grid_blocks), dim3(NTHREADS), args, LDS_BYTES, stream);
    if (e != hipSuccess) fprintf(stderr, "kernel_launch: cooperative launch failed: %s (grid %d)\n", hipGetErrorString(e), grid_blocks);
}
```

```cpp
#include <hip/hip_runtime.h>
#include <hip/hip_cooperative_groups.h>
#include <cstdio>
#include <cstdint>
namespace cg = cooperative_groups;
namespace pg8 {
#define PG8_LAS __attribute__((address_space(3)))
typedef unsigned short bf16_t;
typedef short bf16x8 __attribute__((ext_vector_type(8)));
typedef float f32x4 __attribute__((ext_vector_type(4)));
typedef unsigned u32x4 __attribute__((ext_vector_type(4)));
constexpr int BM = 256, BK = 64, HALF = 128, HTB = HALF * BK * 2  , STAGE_BYTES = 8 * HTB, NXCD = 8, WGM = 8;

__host__ __device__ __forceinline__ int lds_byte(int r, int c) { const int st = (r >> 4) * 2 + (c >> 5), rr = r & 15, cc = c & 31, ob = rr * 64 + cc * 2; return st * 1024 + (ob ^ (((ob >> 9) & 1) << 5)); }
__host__ __device__ __forceinline__ void stage_rc(int b, int& R, int& C) { const int st = b / 1024, sb = b % 1024, swz = sb ^ (((sb >> 9) & 1) << 5); R = (st >> 1) * 16 + swz / 64; C = (st & 1) * 32 + (swz % 64) / 2; }
__host__ __device__ __forceinline__ int perm32(int rho) { const int n = rho >> 4, i = rho & 15; return 8 * (i >> 2) + 4 * n + (i & 3); }

struct Unit { int pm, pn; };
struct Gemm { const bf16_t* A; const bf16_t* Bt; int M, N, K; };

struct StaticOrder {
    int nM, nN, nwg, G, c;
    __host__ __device__ void init(int M, int N, int G_, int c_) { nM = M / BM; nN = N / BM; nwg = nM * nN; G = G_; c = c_; }
    __host__ __device__ bool next(int i, Unit& u) const {
        const long L = (long)i * G + c; if (L >= nwg) return false;
        int wgid = (int)L; { const int q = nwg / NXCD, r = nwg % NXCD, xcd = wgid % NXCD, off = wgid / NXCD; wgid = (xcd < r ? xcd * (q + 1) : r * (q + 1) + (xcd - r) * q) + off; }
        const int nig = WGM * nN, gid = wgid / nig, fm = gid * WGM, gsz = (nM - fm) < WGM ? (nM - fm) : WGM;
        u.pm = fm + ((wgid % nig) % gsz); u.pn = (wgid % nig) / gsz; return true;
    }
    __device__ __forceinline__ void a_ready(const Unit&) const {}
    __device__ __forceinline__ void done(const Unit&) const {}
};

__device__ __forceinline__ unsigned cvt_pk_bf16(float lo, float hi) { unsigned r; asm volatile("v_cvt_pk_bf16_f32 %0, %1, %2" : "=v"(r) : "v"(lo), "v"(hi)); return r; }
struct EpiH {
    static constexpr bool PERM = true, AFTER_DRAIN = false;
    bf16_t* O; int ldc;
    __device__ __forceinline__ void init(f32x4 (&acc)[2][2][4][2], const Unit&, int, int, int, int) const {
#pragma unroll
        for (int a = 0; a < 2; ++a)
#pragma unroll
            for (int b = 0; b < 2; ++b)
#pragma unroll
                for (int m = 0; m < 4; ++m)
#pragma unroll
                    for (int n = 0; n < 2; ++n) acc[a][b][m][n] = (f32x4){0.f, 0.f, 0.f, 0.f};
    }
    __device__ __forceinline__ void operator()(const f32x4 (&acc)[2][2][4][2], const Unit& u, int wr, int wc, int fr, int fq) const {
        const int row0 = u.pm * BM + wr * 64 + fr, col0 = u.pn * BM + wc * 32 + 8 * fq;
#pragma unroll
        for (int ai = 0; ai < 2; ++ai)
#pragma unroll
            for (int m = 0; m < 4; ++m) { bf16_t* rowp = O + (size_t)(row0 + ai * HALF + m * 16) * ldc + col0;
#pragma unroll
                for (int bj = 0; bj < 2; ++bj) { const f32x4 v0 = acc[ai][bj][m][0], v1 = acc[ai][bj][m][1];
                    u32x4 w; w.x = cvt_pk_bf16(v0[0], v0[1]); w.y = cvt_pk_bf16(v0[2], v0[3]); w.z = cvt_pk_bf16(v1[0], v1[1]); w.w = cvt_pk_bf16(v1[2], v1[3]);
                    *(u32x4*)(rowp + bj * HALF) = w; } }
    }
};
struct EpiRes {
    static constexpr bool PERM = false, AFTER_DRAIN = false;
    const float* xa; const float* xb; float* C; int split_pm;
    __device__ __forceinline__ void init(f32x4 (&acc)[2][2][4][2], const Unit& u, int wr, int wc, int fr, int fq) const {
        const int lrow0 = wr * 64 + fr, col0 = u.pn * BM + wc * 32 + 4 * fq;
        const float* xt = (u.pm < split_pm) ? xa + (size_t)u.pm * BM * 2048 : xb + (size_t)(u.pm - split_pm) * BM * 2048;
#pragma unroll
        for (int ai = 0; ai < 2; ++ai)
#pragma unroll
            for (int m = 0; m < 4; ++m) { const size_t off = (size_t)(lrow0 + ai * HALF + m * 16) * 2048 + col0;
#pragma unroll
                for (int bj = 0; bj < 2; ++bj)
#pragma unroll
                    for (int n = 0; n < 2; ++n) acc[ai][bj][m][n] = *(const f32x4*)(xt + off + bj * HALF + n * 16); }
    }
    __device__ __forceinline__ void operator()(const f32x4 (&acc)[2][2][4][2], const Unit& u, int wr, int wc, int fr, int fq) const {
        const int lrow0 = wr * 64 + fr, col0 = u.pn * BM + wc * 32 + 4 * fq;
        float* ct = C + (size_t)u.pm * BM * 2048;
#pragma unroll
        for (int ai = 0; ai < 2; ++ai)
#pragma unroll
            for (int m = 0; m < 4; ++m) { const size_t off = (size_t)(lrow0 + ai * HALF + m * 16) * 2048 + col0;
#pragma unroll
                for (int bj = 0; bj < 2; ++bj)
#pragma unroll
                    for (int n = 0; n < 2; ++n) *(f32x4*)(ct + off + bj * HALF + n * 16) = acc[ai][bj][m][n]; }
    }
};
struct OneUnit {
    int pm, pn;
    __device__ __forceinline__ bool next(int i, Unit& u) const { if (i != 0) return false; u.pm = pm; u.pn = pn; return true; }
    __device__ __forceinline__ void a_ready(const Unit&) const {}
    __device__ __forceinline__ void done(const Unit&) const {}
};
template <class Epi, class Sched, bool ALIGN_EPI = false, bool SP2 = false>
__device__ __forceinline__ void gemm_phase(PG8_LAS unsigned char* lds, const Gemm g, const Sched& S, const Epi& E) {
    int tid_ = threadIdx.x; asm volatile("" : "+v"(tid_));
    const int tid = tid_, wid = __builtin_amdgcn_readfirstlane(tid >> 6), lane = tid & 63, wr = wid >> 2, wc = wid & 3, fr = lane & 15, fq = lane >> 4;
    const int K = g.K, nt = K / BK;
    unsigned voffA[2], voffB[2];
#pragma unroll
    for (int i = 0; i < 2; ++i) { int R, C; stage_rc(tid * 16 + i * 8192, R, C); const int Rb = Epi::PERM ? ((R & ~31) + perm32(R & 31)) : R;
        voffA[i] = (unsigned)(R * K + C) * 2u; voffB[i] = (unsigned)(Rb * K + C) * 2u; }
    const size_t kstep = (size_t)(BK * 2);
    const size_t hstep = (size_t)HALF * K * 2;
    const size_t tstep = 2 * hstep;
    const unsigned ldsw = (unsigned)wid * 1024u;
    const int aoff = lds_byte(wr * 64 + fr, fq * 8), boff = lds_byte(wc * 32 + fr, fq * 8);
#define PG8_SA(b, h) (((b) * 2 + (h)) * HTB)
#define PG8_SB(b, h) ((4 + (b) * 2 + (h)) * HTB)
#define PG8_STAGE(bufoff, gbase, voff) do { _Pragma("unroll") for (int _i = 0; _i < 2; ++_i) \
        __builtin_amdgcn_global_load_lds((const unsigned*)((const char*)(gbase) + (voff)[_i]), (PG8_LAS unsigned*)(lds + (bufoff) + ldsw + _i * 8192), 16, 0, 0); } while (0)
#define PG8_LDA(dst, b, h) do { _Pragma("unroll") for (int m = 0; m < 4; ++m) _Pragma("unroll") for (int k = 0; k < 2; ++k) dst[m][k] = *(const PG8_LAS bf16x8*)(lds + PG8_SA(b, h) + aoff + m * 2048 + k * 1024); } while (0)
#define PG8_LDB(dst, b, h) do { _Pragma("unroll") for (int n = 0; n < 2; ++n) _Pragma("unroll") for (int k = 0; k < 2; ++k) dst[n][k] = *(const PG8_LAS bf16x8*)(lds + PG8_SB(b, h) + boff + n * 2048 + k * 1024); } while (0)
#define PG8_MMA(ai, bj, At, Bt) do { __builtin_amdgcn_s_setprio(1); _Pragma("unroll") for (int m = 0; m < 4; ++m) _Pragma("unroll") for (int n = 0; n < 2; ++n) _Pragma("unroll") for (int k = 0; k < 2; ++k) \
        acc[ai][bj][m][n] = __builtin_amdgcn_mfma_f32_16x16x32_bf16(Bt[n][k], At[m][k], acc[ai][bj][m][n], 0, 0, 0); __builtin_amdgcn_s_setprio(0); } while (0)
#define PG8_WAIT_V(n) asm volatile("s_waitcnt vmcnt(" #n ")" ::: "memory")
#define PG8_WAIT_L(n) asm volatile("s_waitcnt lgkmcnt(" #n ")" ::: "memory")
#define PG8_BAR __builtin_amdgcn_s_barrier()
#define PG8_SCHED __builtin_amdgcn_sched_barrier(0)
    Unit cur, nxt; int ui = 0;
    if (!S.next(0, cur)) return;
    f32x4 acc[2][2][4][2];
    E.init(acc, cur, wr, wc, fr, fq);
    bf16x8 At[4][2], B0[2][2], B1[2][2];
    const char* cA = (const char*)g.A + (size_t)cur.pm * tstep; const char* cB = (const char*)g.Bt + (size_t)cur.pn * tstep;
    S.a_ready(cur);
    if constexpr (SP2) {
        PG8_STAGE(PG8_SB(0, 0), cB, voffB); PG8_STAGE(PG8_SB(0, 1), cB + hstep, voffB); PG8_STAGE(PG8_SA(0, 0), cA, voffA); PG8_STAGE(PG8_SA(0, 1), cA + hstep, voffA);
        if (wr == 1) PG8_BAR;
        PG8_WAIT_V(2); PG8_BAR;
        PG8_STAGE(PG8_SB(1, 0), cB + kstep, voffB); PG8_STAGE(PG8_SA(1, 0), cA + kstep, voffA); PG8_STAGE(PG8_SB(1, 1), cB + hstep + kstep, voffB);
        PG8_WAIT_V(6); PG8_BAR;
    } else {
        PG8_STAGE(PG8_SB(0, 0), cB, voffB); PG8_STAGE(PG8_SA(0, 0), cA, voffA); PG8_STAGE(PG8_SB(0, 1), cB + hstep, voffB); PG8_STAGE(PG8_SA(0, 1), cA + hstep, voffA);
        if (wr == 1) PG8_BAR;
        PG8_WAIT_V(4); PG8_BAR;
        PG8_STAGE(PG8_SB(1, 0), cB + kstep, voffB); PG8_STAGE(PG8_SA(1, 0), cA + kstep, voffA); PG8_STAGE(PG8_SB(1, 1), cB + hstep + kstep, voffB);
        PG8_WAIT_V(6); PG8_BAR;
    }
    for (;;) {
        const bool has_next = S.next(ui + 1, nxt);
        const char* nA = has_next ? (const char*)g.A + (size_t)nxt.pm * tstep : cA; const char* nB = has_next ? (const char*)g.Bt + (size_t)nxt.pn * tstep : cB;
        for (int t = 0; t < nt; t += 2) {
            const bool last = (t == nt - 2);
            const char* a1 = cA + (size_t)(t + 1) * kstep;
            const char* a2 = last ? nA : cA + (size_t)(t + 2) * kstep; const char* b2 = last ? nB : cB + (size_t)(t + 2) * kstep;
            const char* a3 = a2 + kstep; const char* b3 = b2 + kstep;
            if (last && has_next) S.a_ready(nxt);
            if constexpr (SP2) {
            PG8_LDB(B0, 0, 0); PG8_LDB(B1, 0, 1); PG8_SCHED; PG8_LDA(At, 0, 0); PG8_STAGE(PG8_SA(1, 1), a1 + hstep, voffA);
            PG8_WAIT_V(8); PG8_WAIT_L(0); PG8_BAR; PG8_MMA(0, 0, At, B0); PG8_MMA(0, 1, At, B1); PG8_BAR; PG8_SCHED;
            PG8_LDA(At, 0, 1); PG8_STAGE(PG8_SB(0, 0), b2, voffB); PG8_STAGE(PG8_SB(0, 1), b2 + hstep, voffB); PG8_STAGE(PG8_SA(0, 0), a2, voffA);
            PG8_WAIT_V(8); PG8_WAIT_L(0); PG8_BAR; PG8_MMA(1, 0, At, B0); PG8_MMA(1, 1, At, B1); PG8_BAR; PG8_SCHED;
            PG8_LDB(B0, 1, 0); PG8_LDB(B1, 1, 1); PG8_SCHED; PG8_LDA(At, 1, 0); PG8_STAGE(PG8_SA(0, 1), a2 + hstep, voffA);
            PG8_WAIT_V(8); PG8_WAIT_L(0); PG8_BAR; PG8_MMA(0, 0, At, B0); PG8_MMA(0, 1, At, B1); PG8_BAR; PG8_SCHED;
            PG8_LDA(At, 1, 1); PG8_STAGE(PG8_SB(1, 0), b3, voffB); PG8_STAGE(PG8_SB(1, 1), b3 + hstep, voffB); PG8_STAGE(PG8_SA(1, 0), a3, voffA);
            PG8_WAIT_V(8); PG8_WAIT_L(0); PG8_BAR; PG8_MMA(1, 0, At, B0); PG8_MMA(1, 1, At, B1); PG8_BAR; PG8_SCHED;
            } else {
            PG8_LDB(B0, 0, 0); PG8_SCHED; PG8_LDA(At, 0, 0); PG8_STAGE(PG8_SA(1, 1), a1 + hstep, voffA);
            PG8_WAIT_L(8); PG8_BAR; PG8_WAIT_L(0); PG8_MMA(0, 0, At, B0); PG8_BAR; PG8_SCHED;
            PG8_LDB(B1, 0, 1); PG8_STAGE(PG8_SB(0, 0), b2, voffB);
            PG8_BAR; PG8_WAIT_L(0); PG8_MMA(0, 1, At, B1); PG8_BAR;
            PG8_LDA(At, 0, 1); PG8_STAGE(PG8_SA(0, 0), a2, voffA);
            PG8_BAR; PG8_WAIT_L(0); PG8_MMA(1, 0, At, B0); PG8_BAR; PG8_SCHED;
            PG8_STAGE(PG8_SB(0, 1), b2 + hstep, voffB);
            PG8_WAIT_V(6); PG8_BAR; PG8_MMA(1, 1, At, B1); PG8_BAR;
            PG8_LDB(B0, 1, 0); PG8_SCHED; PG8_LDA(At, 1, 0); PG8_STAGE(PG8_SA(0, 1), a2 + hstep, voffA);
            PG8_WAIT_L(8); PG8_BAR; PG8_WAIT_L(0); PG8_MMA(0, 0, At, B0); PG8_BAR; PG8_SCHED;
            PG8_LDB(B1, 1, 1); PG8_STAGE(PG8_SB(1, 0), b3, voffB);
            PG8_BAR; PG8_WAIT_L(0); PG8_MMA(0, 1, At, B1); PG8_BAR;
            PG8_LDA(At, 1, 1); PG8_STAGE(PG8_SA(1, 0), a3, voffA);
            PG8_BAR; PG8_WAIT_L(0); PG8_MMA(1, 0, At, B0); PG8_BAR; PG8_SCHED;
            PG8_STAGE(PG8_SB(1, 1), b3 + hstep, voffB);
            PG8_WAIT_V(6); PG8_BAR; PG8_MMA(1, 1, At, B1); PG8_BAR;
            }
        }
        if constexpr (ALIGN_EPI) { if (wr == 0) PG8_BAR; }
        if constexpr (!Epi::AFTER_DRAIN) { E(acc, cur, wr, wc, fr, fq); S.done(cur); }
        if (!has_next) break;
        E.init(acc, nxt, wr, wc, fr, fq);
        cur = nxt; cA = nA; cB = nB; ++ui;
        if constexpr (ALIGN_EPI) { if (wr == 1) PG8_BAR; }
    }
    PG8_WAIT_V(0);
    if constexpr (!ALIGN_EPI) { if (wr == 0) PG8_BAR; }
    PG8_BAR;
    if constexpr (Epi::AFTER_DRAIN) { E.fused(acc, cur, wr, wc, fr, fq, lds, wid, lane); S.done(cur); }
#undef PG8_SA
#undef PG8_SB
#undef PG8_STAGE
#undef PG8_LDA
#undef PG8_LDB
#undef PG8_MMA
#undef PG8_WAIT_V
#undef PG8_WAIT_L
#undef PG8_BAR
#undef PG8_SCHED
}
}
#define LAS __attribute__((address_space(3)))
#define DI __device__ __forceinline__
typedef unsigned short bf16;
typedef short bf16x8 __attribute__((ext_vector_type(8)));
typedef float f32x4 __attribute__((ext_vector_type(4)));
typedef float f32x16 __attribute__((ext_vector_type(16)));
typedef unsigned u32x4 __attribute__((ext_vector_type(4)));
typedef unsigned u32x2 __attribute__((ext_vector_type(2)));
typedef float f32x2_t __attribute__((ext_vector_type(2)));
typedef __bf16 bf16x2_t __attribute__((ext_vector_type(2)));

constexpr int DM = 2048, NB = 8, SEQL = 4096, DECB = 16, DECS = 16;
constexpr int MP = NB * SEQL, MS = DECB * DECS, MT = MP + MS;
constexpr int NIN = 5648, LDH = 5888;
constexpr int C_QA = 0, C_KA = 1024, C_VA = 1280, C_GA = 1536, C_QG = 2560, C_KG = 3072, C_VG = 3584, C_GG = 4608, C_LR = 5632;
constexpr float EPS = 1e-6f;
constexpr size_t MiB = 1u << 20;
constexpr size_t WS_WG = 0, WS_WO = 24 * MiB, WS_XB = 32 * MiB, WS_MIX = 161 * MiB, WS_H = 290 * MiB, WS_L = 662 * MiB, WS_D = 694 * MiB, WS_KT = 695 * MiB, WS_DV = 728 * MiB, WS_CTL = 730 * MiB, WS_END = 731 * MiB;
static_assert(WS_H + (size_t)MT * LDH * 2 <= WS_L && (size_t)LDH * DM * 2 <= WS_WO && WS_XB + (size_t)MT * DM * 2 <= WS_MIX && WS_MIX + (size_t)MT * DM * 2 <= WS_H, "ws map");
constexpr size_t O_YP = 0, O_YS = (size_t)MP * DM, O_WKP = O_YS + (size_t)MS * DM, O_WVP = O_WKP + 262144, O_GP = O_WVP + 262144,
                 O_WKS = O_GP + 1048576, O_WVS = O_WKS + 524288, O_GS = O_WVS + 524288, O_END = O_GS + 2097152;
constexpr int LDS_BYTES = 155648;
constexpr int NTHREADS = 512;
constexpr int LDS_ST_OFF = LDS_BYTES - 64;

struct Params {
    const float *x_p, *x_s, *cache_k, *cache_v, *state, *norm_g, *w_in, *w_gu, *b_gate, *qng, *kng, *sinks, *gng, *w_out;
    float* out; unsigned char* ws;
};

DI unsigned pk2(float lo, float hi) { f32x2_t v = {lo, hi}; bf16x2_t b = __builtin_convertvector(v, bf16x2_t); return __builtin_bit_cast(unsigned, b); }
DI float bflo(unsigned u) { return __uint_as_float(u << 16); }
DI float bfhi(unsigned u) { return __uint_as_float(u & 0xffff0000u); }
DI float wave_sum(float v) {
#pragma unroll
    for (int o = 1; o < 64; o <<= 1) v += __shfl_xor(v, o);
    return v;
}
DI float silu(float x) { return x / (1.f + __expf(-x)); }
#define BAR_LDS() do { asm volatile("s_waitcnt lgkmcnt(0)" ::: "memory"); __builtin_amdgcn_s_barrier(); asm volatile("" ::: "memory"); } while (0)
#define MFMA32(a, b, c) __builtin_amdgcn_mfma_f32_32x32x16_bf16((a), (b), (c), 0, 0, 0)
DI f32x16 zero16() { f32x16 z;
#pragma unroll
    for (int i = 0; i < 16; ++i) z[i] = 0.f;
    return z; }
template <int S> DI bf16x8 pack_step(const f32x16& x) {
    u32x4 p; p.x = pk2(x[8 * S + 0], x[8 * S + 1]); p.y = pk2(x[8 * S + 2], x[8 * S + 3]); p.z = pk2(x[8 * S + 4], x[8 * S + 5]); p.w = pk2(x[8 * S + 6], x[8 * S + 7]);
    return __builtin_bit_cast(bf16x8, p);
}
DI bf16x8 lds_b128(LAS const unsigned char* p) { return *(LAS const bf16x8*)p; }
DI bf16x8 lds_2xb64(LAS const unsigned char* p0, LAS const unsigned char* p1) {
    const u32x2 a = *(LAS const u32x2*)p0, b = *(LAS const u32x2*)p1; u32x4 r; r.x = a.x; r.y = a.y; r.z = b.x; r.w = b.y; return __builtin_bit_cast(bf16x8, r);
}

DI void p0_transpose_item(const float* W, const float* rs, int K, int N, bf16* WT, LAS float* scr, int item, int lane) {
    const int nblk = (N + 31) / 32, kb = item / nblk, nb = item % nblk, k0 = 64 * kb, n0 = 32 * nb;
#pragma unroll 8
    for (int i = 0; i < 32; ++i) { const int kk = 2 * i + (lane >> 5), n = n0 + (lane & 31);
        float v = (n < N) ? W[(size_t)(k0 + kk) * N + n] : 0.f; if (rs) v *= rs[k0 + kk];
        scr[kk * 33 + (lane & 31)] = v; }
    asm volatile("s_waitcnt lgkmcnt(0)" ::: "memory");
    const int c = lane & 7;
#pragma unroll
    for (int j = 0; j < 4; ++j) { const int n = (lane >> 3) + 8 * j; LAS const float* s = scr + (8 * c) * 33 + n;
        u32x4 o; o.x = pk2(s[0 * 33], s[1 * 33]); o.y = pk2(s[2 * 33], s[3 * 33]); o.z = pk2(s[4 * 33], s[5 * 33]); o.w = pk2(s[6 * 33], s[7 * 33]);
        *(u32x4*)(WT + (size_t)(n0 + n) * K + k0 + 8 * c) = o; }
    asm volatile("s_waitcnt lgkmcnt(0)" ::: "memory");
}
DI void p0_prologue(const Params& P, LAS unsigned char* lds, int tid) {
    const int lane = tid & 63, wave = tid >> 6, G = gridDim.x;
    const int gw = blockIdx.x * 8 + wave, NGW = G * 8;
    LAS float* scr = (LAS float*)(lds + wave * 16384);
    bf16* WG = (bf16*)(P.ws + WS_WG); bf16* WO = (bf16*)(P.ws + WS_WO); bf16* XB = (bf16*)(P.ws + WS_XB);
    constexpr int I_IN = (DM / 64) * ((NIN + 31) / 32), I_OUT = (DM / 64) * (DM / 32);
    for (int it = gw; it < I_IN + I_OUT; it += NGW) {
        if (it < I_IN) p0_transpose_item(P.w_in, P.norm_g, DM, NIN, WG, scr, it, lane);
        else p0_transpose_item(P.w_out, nullptr, DM, DM, WO, scr, it - I_IN, lane);
    }
    { const size_t n16 = (size_t)(LDH - 5664) * DM * 2 / 16; u32x4* z = (u32x4*)(WG + (size_t)5664 * DM);
      for (size_t i = (size_t)blockIdx.x * NTHREADS + tid; i < n16; i += (size_t)G * NTHREADS) z[i] = (u32x4){0u, 0u, 0u, 0u}; }
    for (int r = gw; r < MT; r += NGW) {
        const float* src = (r < MP) ? P.x_p + (size_t)r * DM : P.x_s + (size_t)(r - MP) * DM;
        const f32x4* xr = (const f32x4*)src + lane;
        f32x4 v[8]; float s = 0.f;
#pragma unroll
        for (int j = 0; j < 8; ++j) { v[j] = xr[64 * j]; s += (v[j].x * v[j].x + v[j].y * v[j].y) + (v[j].z * v[j].z + v[j].w * v[j].w); }
        const float rstd = rsqrtf(wave_sum(s) * (1.f / DM) + EPS);
        u32x2* o8 = (u32x2*)(XB + (size_t)r * DM) + lane;
#pragma unroll
        for (int j = 0; j < 8; ++j) { u32x2 w; w.x = pk2(v[j].x * rstd, v[j].y * rstd); w.y = pk2(v[j].z * rstd, v[j].w * rstd); o8[64 * j] = w; }
    }
}
#define XB_TMO      128
#define XB_XCNT(j)  (256  + 64 * (j))
#define XB_XSUB(j)  (1280 + 64 * (j))
#define XB_XGEN(j)  (2304 + 64 * (j))
#define XB_TOP      3328
#define XB_TOPGEN   3392
#define XCD_BAR_WORDS 3456
#define XB_SPIN_CAP (1u << 18)

__device__ __forceinline__ unsigned xb_ld(unsigned* p)              { return __hip_atomic_load(p, __ATOMIC_RELAXED, __HIP_MEMORY_SCOPE_AGENT); }
__device__ __forceinline__ unsigned xb_add(unsigned* p, unsigned v) { return __hip_atomic_fetch_add(p, v, __ATOMIC_RELAXED, __HIP_MEMORY_SCOPE_AGENT); }
__device__ __forceinline__ unsigned xb_xcc_id() { return (unsigned)__builtin_amdgcn_s_getreg((3 << 11) | 20) & 0xFu; }
#define XB_SPIN(cond, bar) do { unsigned _sp = 0; while (cond) { __builtin_amdgcn_s_sleep(1); \
    if ((++_sp & 255u) == 0u) { if (xb_ld(&(bar)[XB_TMO])) break; if (_sp > XB_SPIN_CAP) { atomicAdd(&(bar)[XB_TMO], 1u); break; } } } } while (0)

struct XcdBarrier {
    unsigned* bar; unsigned x;
    volatile LAS unsigned* st;
};

__device__ __forceinline__ XcdBarrier xcd_barrier_post(unsigned* bar, volatile LAS unsigned* st) {
    XcdBarrier b; b.bar = bar; b.x = xb_xcc_id(); b.st = st;
    if (threadIdx.x == 0) (void)xb_add(&bar[XB_XCNT(b.x)], 1u);
    return b;
}
__device__ __forceinline__ void xcd_barrier_complete(unsigned* bar, unsigned x, unsigned& nloc, unsigned& nx) {
    const unsigned G = gridDim.x * gridDim.y * gridDim.z;
    unsigned sum, cnt, mine, sp = 0u;
    for (;;) {
        sum = 0u; cnt = 0u; mine = 0u;
#pragma unroll
        for (unsigned j = 0; j < 16; ++j) { const unsigned c = xb_ld(&bar[XB_XCNT(j)]); sum += c; cnt += (c > 0u) ? 1u : 0u; mine = (j == x) ? c : mine; }
        if (sum == G) break;
        __builtin_amdgcn_s_sleep(1);
        if ((++sp & 255u) == 0u) { if (xb_ld(&bar[XB_TMO])) break; if (sp > XB_SPIN_CAP) { atomicAdd(&bar[XB_TMO], 1u); break; } }
    }
    nloc = mine > 0u ? mine : 1u; nx = cnt > 0u ? cnt : 1u;
}

__device__ __forceinline__ void xcd_barrier(const XcdBarrier& b) {
    asm volatile("s_waitcnt vmcnt(0)" ::: "memory");
    __syncthreads();
    if (threadIdx.x == 0) {
        unsigned* bar = b.bar;
        __builtin_amdgcn_s_waitcnt(0);
        unsigned nloc = b.st[0], nx = b.st[1];
        if (nloc == 0u) { xcd_barrier_complete(bar, b.x, nloc, nx); b.st[0] = nloc; b.st[1] = nx; }
        const unsigned old = xb_add(&bar[XB_XSUB(b.x)], 1u);
        const unsigned gen = old / nloc;
        if (old + 1u == (gen + 1u) * nloc) {
            __builtin_amdgcn_fence(__ATOMIC_RELEASE, "agent");
            asm volatile("s_waitcnt vmcnt(0)" ::: "memory");
            const unsigned og = xb_add(&bar[XB_TOP], 1u);
            const unsigned tg = og / nx;
            if (og + 1u == (tg + 1u) * nx) xb_add(&bar[XB_TOPGEN], 1u);
            else XB_SPIN(xb_ld(&bar[XB_TOPGEN]) == tg, bar);
            __builtin_amdgcn_fence(__ATOMIC_ACQUIRE, "agent");
            xb_add(&bar[XB_XGEN(b.x)], 1u);
            asm volatile("s_waitcnt vmcnt(0)" ::: "memory");
        } else {
            XB_SPIN(xb_ld(&bar[XB_XGEN(b.x)]) == gen, bar);
            __builtin_amdgcn_fence(__ATOMIC_ACQUIRE, "agent");
            asm volatile("s_waitcnt vmcnt(0)" ::: "memory");
        }
    }
    __syncthreads();
}
DI void load8_h(const bf16* p, float (&v)[8]) { const u32x4 r = *(const u32x4*)p; v[0] = bflo(r.x); v[1] = bfhi(r.x); v[2] = bflo(r.y); v[3] = bfhi(r.y); v[4] = bflo(r.z); v[5] = bfhi(r.z); v[6] = bflo(r.w); v[7] = bfhi(r.w); }
DI void load8_f(const float* p, float (&v)[8]) { const f32x4 a = *(const f32x4*)p, b = *(const f32x4*)(p + 4); v[0] = a.x; v[1] = a.y; v[2] = a.z; v[3] = a.w; v[4] = b.x; v[5] = b.y; v[6] = b.z; v[7] = b.w; }
DI void store8_f(float* p, const float (&v)[8]) { *(f32x4*)p = (f32x4){v[0], v[1], v[2], v[3]}; *(f32x4*)(p + 4) = (f32x4){v[4], v[5], v[6], v[7]}; }
DI void norm8(float (&v)[8], const float* g, int part, float extra) {
    float ss = 0.f;
#pragma unroll
    for (int i = 0; i < 8; ++i) ss += v[i] * v[i];
    ss += __shfl_xor(ss, 1); ss += __shfl_xor(ss, 2); ss += __shfl_xor(ss, 4);
    const float rs = rsqrtf(ss * (1.f / 64.f) + EPS) * extra;
    const f32x4 g0 = *(const f32x4*)(g + part * 8), g1 = *(const f32x4*)(g + part * 8 + 4);
    v[0] *= rs * g0.x; v[1] *= rs * g0.y; v[2] *= rs * g0.z; v[3] *= rs * g0.w; v[4] *= rs * g1.x; v[5] *= rs * g1.y; v[6] *= rs * g1.z; v[7] *= rs * g1.w;
}
DI void win_items(const Params& P, int tid) {
    const bf16* H = (const bf16*)(P.ws + WS_H);
    const int ngrp = 4096 + 8192;
    for (int gt = blockIdx.x * NTHREADS + tid; gt < ((ngrp * 8 + 63) & ~63); gt += gridDim.x * NTHREADS) {
        int grp = gt >> 3; const int part = gt & 7; const bool act = grp < ngrp; if (!act) grp = 0;
        float kv[8], vv[8]; float* ok; float* ov; bool do_norm = true;
        if (grp < 4096) { const int b = grp >> 9, j = (grp >> 2) & 127, g = grp & 3; const size_t hrow = (size_t)b * SEQL + (SEQL - 128) + j;
            load8_h(H + hrow * LDH + C_KA + g * 64 + part * 8, kv); load8_h(H + hrow * LDH + C_VA + g * 64 + part * 8, vv);
            const size_t o = ((size_t)(b * 128 + j) * 4 + g) * 64 + part * 8; ok = P.out + O_WKP + o; ov = P.out + O_WVP + o; }
        else { const int s = grp - 4096, b = s >> 9, j = (s >> 2) & 127, g = s & 3;
            const size_t o = ((size_t)(b * 128 + j) * 4 + g) * 64 + part * 8; ok = P.out + O_WKS + o; ov = P.out + O_WVS + o;
            if (j < 112) { const size_t ci = ((size_t)(b * 128 + j + 16) * 4 + g) * 64 + part * 8; load8_f(P.cache_k + ci, kv); load8_f(P.cache_v + ci, vv); do_norm = false; }
            else { const size_t hrow = (size_t)MP + b * DECS + (j - 112);
                load8_h(H + hrow * LDH + C_KA + g * 64 + part * 8, kv); load8_h(H + hrow * LDH + C_VA + g * 64 + part * 8, vv); } }
        float kn[8];
#pragma unroll
        for (int i = 0; i < 8; ++i) kn[i] = kv[i];
        norm8(kn, P.kng, part, 1.f);
        if (do_norm) {
#pragma unroll
            for (int i = 0; i < 8; ++i) kv[i] = kn[i]; }
        if (act) { store8_f(ok, kv); store8_f(ov, vv); }
    }
}

constexpr int AK_STRIDE = 144, AV_STRIDE = 400, AO_STRIDE = 144;
constexpr int A_K_OFF = 0, A_V_OFF = 192 * AK_STRIDE  , A_O_OFF = A_V_OFF + 64 * AV_STRIDE  , A_END = A_O_OFF + 8 * 32 * AO_STRIDE  ;
static_assert(A_END <= LDS_BYTES, "attention LDS");
DI void att_unit(const Params& P, LAS unsigned char* lds, int tid, int u) {
    asm volatile("" : "+v"(tid));
    const bf16* H = (const bf16*)(P.ws + WS_H); bf16* MIX = (bf16*)(P.ws + WS_MIX);
    const int lane = tid & 63, w = tid >> 6, r32 = lane & 31, hh = lane >> 5;
    const bool sample = u >= 2048;
    int b, c, g; if (!sample) { b = u >> 8; c = (u >> 2) & 63; g = u & 3; } else { const int v = u - 2048; b = v >> 2; c = 0; g = v & 3; }
    const int j_lo = sample ? 0 : ((c >= 2) ? 0 : (2 - c) * 64), j_hi = sample ? 144 : 192;
    const size_t krow0 = sample ? (size_t)MP + b * DECS - 128 : (size_t)b * SEQL + (size_t)(c - 2) * 64;
#pragma unroll
    for (int i = 0; i < 3; ++i) { const int p = tid + NTHREADS * i, key = p >> 3, part = p & 7;
        const bool valid = key >= j_lo && key < j_hi, cached = sample && key < 128;
        float kv[8];
#pragma unroll
        for (int e = 0; e < 8; ++e) kv[e] = 0.f;
        if (valid) { if (cached) load8_f(P.cache_k + ((size_t)(b * 128 + key) * 4 + g) * 64 + part * 8, kv); else load8_h(H + (krow0 + key) * LDH + C_KA + g * 64 + part * 8, kv); }
        float kn[8];
#pragma unroll
        for (int e = 0; e < 8; ++e) kn[e] = kv[e];
        norm8(kn, P.kng, part, 1.f);
        if (!cached) {
#pragma unroll
            for (int e = 0; e < 8; ++e) kv[e] = kn[e]; }
        u32x4 o; o.x = pk2(kv[0], kv[1]); o.y = pk2(kv[2], kv[3]); o.z = pk2(kv[4], kv[5]); o.w = pk2(kv[6], kv[7]);
        *(LAS u32x4*)(lds + A_K_OFF + key * AK_STRIDE + part * 16) = o; }
#pragma unroll
    for (int it = 0; it < 2; ++it) { const int q = tid + NTHREADS * it;
        if (q < 768) { const int kp = q % 96, part = q / 96; float v0[8], v1[8];
#pragma unroll
            for (int e = 0; e < 8; ++e) { v0[e] = 0.f; v1[e] = 0.f; }
            const int k0 = 2 * kp, k1 = 2 * kp + 1;
            if (k0 >= j_lo && k0 < j_hi) { if (sample && k0 < 128) load8_f(P.cache_v + ((size_t)(b * 128 + k0) * 4 + g) * 64 + part * 8, v0); else load8_h(H + (krow0 + k0) * LDH + C_VA + g * 64 + part * 8, v0); }
            if (k1 >= j_lo && k1 < j_hi) { if (sample && k1 < 128) load8_f(P.cache_v + ((size_t)(b * 128 + k1) * 4 + g) * 64 + part * 8, v1); else load8_h(H + (krow0 + k1) * LDH + C_VA + g * 64 + part * 8, v1); }
#pragma unroll
            for (int e = 0; e < 8; ++e) *(LAS unsigned*)(lds + A_V_OFF + (8 * part + e) * AV_STRIDE + kp * 4) = pk2(v0[e], v1[e]); } }
    const int r = w >> 1, th = w & 1, tl = 32 * th + r32, hq = g * 4 + r;
    const bool qvalid = sample ? (tl < DECS) : true;
    const size_t qrow = sample ? (size_t)MP + b * DECS + (qvalid ? tl : 0) : (size_t)b * SEQL + (size_t)c * 64 + tl;
    bf16x8 qf[4];
    { float qv[4][8]; float ss = 0.f;
#pragma unroll
      for (int s = 0; s < 4; ++s) { load8_h(H + qrow * LDH + C_QA + hq * 64 + 16 * s + 8 * hh, qv[s]);
#pragma unroll
          for (int e = 0; e < 8; ++e) ss += qv[s][e] * qv[s][e]; }
      ss += __shfl_xor(ss, 32);
      const float rs = rsqrtf(ss * (1.f / 64.f) + EPS) * 0.125f;
#pragma unroll
      for (int s = 0; s < 4; ++s) { const f32x4 g0 = *(const f32x4*)(P.qng + 16 * s + 8 * hh), g1 = *(const f32x4*)(P.qng + 16 * s + 8 * hh + 4);
          u32x4 o; o.x = pk2(qv[s][0] * rs * g0.x, qv[s][1] * rs * g0.y); o.y = pk2(qv[s][2] * rs * g0.z, qv[s][3] * rs * g0.w);
          o.z = pk2(qv[s][4] * rs * g1.x, qv[s][5] * rs * g1.y); o.w = pk2(qv[s][6] * rs * g1.z, qv[s][7] * rs * g1.w); qf[s] = __builtin_bit_cast(bf16x8, o); } }
    const float sink = P.sinks[hq];
    __syncthreads();
    f32x16 oacc[2]; oacc[0] = zero16(); oacc[1] = zero16();
    float m = sink, l = 0.f;
#pragma unroll
    for (int t = 0; t < 6; ++t) {
        if (32 * t + 32 > j_lo && 32 * t < j_hi) {
            f32x16 a = zero16();
#pragma unroll
            for (int s = 0; s < 4; ++s) a = MFMA32(lds_b128(lds + A_K_OFF + (32 * t + r32) * AK_STRIDE + (16 * s + 8 * hh) * 2), qf[s], a);
            float tm = -INFINITY;
#pragma unroll
            for (int e = 0; e < 16; ++e) { const int key = 32 * t + 8 * (e >> 2) + 4 * hh + (e & 3); const bool ok = key >= j_lo && key < j_hi;
                a[e] = ok ? a[e] : -INFINITY; tm = fmaxf(tm, a[e]); }
            tm = fmaxf(tm, __shfl_xor(tm, 32));
            const float mn = fmaxf(m, tm), sc = __expf(m - mn); m = mn;
            float ls = 0.f;
#pragma unroll
            for (int e = 0; e < 16; ++e) { const float p = __expf(a[e] - m); a[e] = p; ls += p; }
            l = l * sc + ls;
#pragma unroll
            for (int e = 0; e < 16; ++e) { oacc[0][e] *= sc; oacc[1][e] *= sc; }
            const bf16x8 p0 = pack_step<0>(a), p1 = pack_step<1>(a);
#pragma unroll
            for (int dt = 0; dt < 2; ++dt) {
                LAS const unsigned char* vb = lds + A_V_OFF + (32 * dt + r32) * AV_STRIDE + (32 * t + 4 * hh) * 2;
                oacc[dt] = MFMA32(lds_2xb64(vb, vb + 16), p0, oacc[dt]);
                oacc[dt] = MFMA32(lds_2xb64(vb + 32, vb + 48), p1, oacc[dt]);
            }
        }
    }
    l += __shfl_xor(l, 32);
    l += __expf(sink - m);
    const float inv_l = 1.f / l;
    LAS unsigned char* ost = lds + A_O_OFF + w * 32 * AO_STRIDE;
#pragma unroll
    for (int dt = 0; dt < 2; ++dt)
#pragma unroll
        for (int q4 = 0; q4 < 4; ++q4) { u32x2 o; o.x = pk2(oacc[dt][4 * q4] * inv_l, oacc[dt][4 * q4 + 1] * inv_l); o.y = pk2(oacc[dt][4 * q4 + 2] * inv_l, oacc[dt][4 * q4 + 3] * inv_l);
            *(LAS u32x2*)(ost + r32 * AO_STRIDE + (32 * dt + 8 * q4 + 4 * hh) * 2) = o; }
    __syncthreads();
#pragma unroll
    for (int it = 0; it < 4; ++it) { const int row = (lane >> 3) + 8 * it, part = lane & 7, t2 = 32 * th + row;
        const bool ok = sample ? (t2 < DECS) : true;
        if (ok) { const size_t hrow = sample ? (size_t)MP + b * DECS + t2 : (size_t)b * SEQL + (size_t)c * 64 + t2;
            const u32x4 ov = *(LAS const u32x4*)(ost + row * AO_STRIDE + part * 16);
            float gv[8]; load8_h(H + hrow * LDH + C_GA + hq * 64 + part * 8, gv);
            u32x4 o; o.x = pk2(bflo(ov.x) * silu(gv[0]), bfhi(ov.x) * silu(gv[1])); o.y = pk2(bflo(ov.y) * silu(gv[2]), bfhi(ov.y) * silu(gv[3]));
            o.z = pk2(bflo(ov.z) * silu(gv[4]), bfhi(ov.z) * silu(gv[5])); o.w = pk2(bflo(ov.w) * silu(gv[6]), bfhi(ov.w) * silu(gv[7]));
            *(u32x4*)(MIX + hrow * DM + hq * 64 + part * 8) = o; } }
}
DI void att_loop(const Params& P, LAS unsigned char* lds, int tid, int begin, int step, int end) {
    asm volatile("" : "+v"(tid));
    const bf16* H = (const bf16*)(P.ws + WS_H); bf16* MIX = (bf16*)(P.ws + WS_MIX);
    const int lane = tid & 63, w = tid >> 6, r32 = lane & 31, hh = lane >> 5;
    const int r = w >> 1, th = w & 1, tl = 32 * th + r32;
    u32x4 kraw[3], vraw[2][2], qraw[4];
#define ATT_ISSUE(U) do { const int b_ = (U) >> 8, c_ = ((U) >> 2) & 63, g_ = (U) & 3; const int jlo_ = (c_ >= 2) ? 0 : (2 - c_) * 64; \
        const size_t krow0_ = (size_t)b_ * SEQL + (size_t)(c_ - 2) * 64; \
        _Pragma("unroll") for (int i_ = 0; i_ < 3; ++i_) { const int p_ = tid + NTHREADS * i_, key_ = p_ >> 3, part_ = p_ & 7; kraw[i_] = (u32x4){0u, 0u, 0u, 0u}; \
            if (key_ >= jlo_) kraw[i_] = *(const u32x4*)(H + (krow0_ + key_) * LDH + C_KA + g_ * 64 + part_ * 8); } \
        _Pragma("unroll") for (int it_ = 0; it_ < 2; ++it_) { const int q_ = tid + NTHREADS * it_, kp_ = q_ % 96, part_ = q_ / 96; \
            vraw[it_][0] = (u32x4){0u, 0u, 0u, 0u}; vraw[it_][1] = (u32x4){0u, 0u, 0u, 0u}; \
            if (q_ < 768 && 2 * kp_ >= jlo_) { vraw[it_][0] = *(const u32x4*)(H + (krow0_ + 2 * kp_) * LDH + C_VA + g_ * 64 + part_ * 8); \
                vraw[it_][1] = *(const u32x4*)(H + (krow0_ + 2 * kp_ + 1) * LDH + C_VA + g_ * 64 + part_ * 8); } } \
        { const size_t qrow_ = (size_t)b_ * SEQL + (size_t)c_ * 64 + tl; \
          _Pragma("unroll") for (int s_ = 0; s_ < 4; ++s_) qraw[s_] = *(const u32x4*)(H + qrow_ * LDH + C_QA + (g_ * 4 + r) * 64 + 16 * s_ + 8 * hh); } } while (0)
    if (begin < end) ATT_ISSUE(begin);
    for (int u = begin; u < end; u += step) {
        const int b = u >> 8, c = (u >> 2) & 63, g = u & 3, hq = g * 4 + r;
        const int j_lo = (c >= 2) ? 0 : (2 - c) * 64; constexpr int j_hi = 192;
#pragma unroll
        for (int i = 0; i < 3; ++i) { const int p = tid + NTHREADS * i, key = p >> 3, part = p & 7;
            float kv[8]; { const u32x4 rw = kraw[i]; kv[0] = bflo(rw.x); kv[1] = bfhi(rw.x); kv[2] = bflo(rw.y); kv[3] = bfhi(rw.y); kv[4] = bflo(rw.z); kv[5] = bfhi(rw.z); kv[6] = bflo(rw.w); kv[7] = bfhi(rw.w); }
            norm8(kv, P.kng, part, 1.f);
            u32x4 o; o.x = pk2(kv[0], kv[1]); o.y = pk2(kv[2], kv[3]); o.z = pk2(kv[4], kv[5]); o.w = pk2(kv[6], kv[7]);
            *(LAS u32x4*)(lds + A_K_OFF + key * AK_STRIDE + part * 16) = o; }
#pragma unroll
        for (int it = 0; it < 2; ++it) { const int q = tid + NTHREADS * it;
            if (q < 768) { const int kp = q % 96, part = q / 96; const u32x4 a = vraw[it][0], bq = vraw[it][1];
                LAS unsigned char* vb = lds + A_V_OFF + (8 * part) * AV_STRIDE + kp * 4;
                *(LAS unsigned*)(vb + 0 * AV_STRIDE) = (a.x & 0xffffu) | (bq.x << 16); *(LAS unsigned*)(vb + 1 * AV_STRIDE) = (a.x >> 16) | (bq.x & 0xffff0000u);
                *(LAS unsigned*)(vb + 2 * AV_STRIDE) = (a.y & 0xffffu) | (bq.y << 16); *(LAS unsigned*)(vb + 3 * AV_STRIDE) = (a.y >> 16) | (bq.y & 0xffff0000u);
                *(LAS unsigned*)(vb + 4 * AV_STRIDE) = (a.z & 0xffffu) | (bq.z << 16); *(LAS unsigned*)(vb + 5 * AV_STRIDE) = (a.z >> 16) | (bq.z & 0xffff0000u);
                *(LAS unsigned*)(vb + 6 * AV_STRIDE) = (a.w & 0xffffu) | (bq.w << 16); *(LAS unsigned*)(vb + 7 * AV_STRIDE) = (a.w >> 16) | (bq.w & 0xffff0000u); } }
        bf16x8 qf[4];
        { float qv[4][8]; float ss = 0.f;
#pragma unroll
          for (int s = 0; s < 4; ++s) { const u32x4 rw = qraw[s]; qv[s][0] = bflo(rw.x); qv[s][1] = bfhi(rw.x); qv[s][2] = bflo(rw.y); qv[s][3] = bfhi(rw.y); qv[s][4] = bflo(rw.z); qv[s][5] = bfhi(rw.z); qv[s][6] = bflo(rw.w); qv[s][7] = bfhi(rw.w);
#pragma unroll
              for (int e = 0; e < 8; ++e) ss += qv[s][e] * qv[s][e]; }
          ss += __shfl_xor(ss, 32);
          const float rs = rsqrtf(ss * (1.f / 64.f) + EPS) * 0.125f;
#pragma unroll
          for (int s = 0; s < 4; ++s) { const f32x4 g0 = *(const f32x4*)(P.qng + 16 * s + 8 * hh), g1 = *(const f32x4*)(P.qng + 16 * s + 8 * hh + 4);
              u32x4 o; o.x = pk2(qv[s][0] * rs * g0.x, qv[s][1] * rs * g0.y); o.y = pk2(qv[s][2] * rs * g0.z, qv[s][3] * rs * g0.w);
              o.z = pk2(qv[s][4] * rs * g1.x, qv[s][5] * rs * g1.y); o.w = pk2(qv[s][6] * rs * g1.z, qv[s][7] * rs * g1.w); qf[s] = __builtin_bit_cast(bf16x8, o); } }
        const float sink = P.sinks[hq];
        u32x4 garaw[4];
#pragma unroll
        for (int it = 0; it < 4; ++it) { const int row = (lane >> 3) + 8 * it, part = lane & 7; const size_t hrow = (size_t)b * SEQL + (size_t)c * 64 + 32 * th + row;
            garaw[it] = *(const u32x4*)(H + hrow * LDH + C_GA + hq * 64 + part * 8); }
        if (u + step < end) ATT_ISSUE(u + step);
        BAR_LDS();
        f32x16 oacc[2]; oacc[0] = zero16(); oacc[1] = zero16();
        float m = sink, l = 0.f;
#pragma unroll
        for (int t = 0; t < 6; ++t) {
            if (32 * t + 32 > j_lo) {
                f32x16 a = zero16();
#pragma unroll
                for (int s = 0; s < 4; ++s) a = MFMA32(lds_b128(lds + A_K_OFF + (32 * t + r32) * AK_STRIDE + (16 * s + 8 * hh) * 2), qf[s], a);
                float tm = -INFINITY;
#pragma unroll
                for (int e = 0; e < 16; ++e) { const int key = 32 * t + 8 * (e >> 2) + 4 * hh + (e & 3); const bool ok = key >= j_lo && key < j_hi;
                    a[e] = ok ? a[e] : -INFINITY; tm = fmaxf(tm, a[e]); }
                tm = fmaxf(tm, __shfl_xor(tm, 32));
                const float mn = fmaxf(m, tm), sc = __expf(m - mn); m = mn;
                float ls = 0.f;
#pragma unroll
                for (int e = 0; e < 16; ++e) { const float p = __expf(a[e] - m); a[e] = p; ls += p; }
                l = l * sc + ls;
#pragma unroll
                for (int e = 0; e < 16; ++e) { oacc[0][e] *= sc; oacc[1][e] *= sc; }
                const bf16x8 p0 = pack_step<0>(a), p1 = pack_step<1>(a);
#pragma unroll
                for (int dt = 0; dt < 2; ++dt) {
                    LAS const unsigned char* vb = lds + A_V_OFF + (32 * dt + r32) * AV_STRIDE + (32 * t + 4 * hh) * 2;
                    oacc[dt] = MFMA32(lds_2xb64(vb, vb + 16), p0, oacc[dt]);
                    oacc[dt] = MFMA32(lds_2xb64(vb + 32, vb + 48), p1, oacc[dt]);
                }
            }
        }
        l += __shfl_xor(l, 32);
        l += __expf(sink - m);
        const float inv_l = 1.f / l;
        LAS unsigned char* ost = lds + A_O_OFF + w * 32 * AO_STRIDE;
#pragma unroll
        for (int dt = 0; dt < 2; ++dt)
#pragma unroll
            for (int q4 = 0; q4 < 4; ++q4) { u32x2 o; o.x = pk2(oacc[dt][4 * q4] * inv_l, oacc[dt][4 * q4 + 1] * inv_l); o.y = pk2(oacc[dt][4 * q4 + 2] * inv_l, oacc[dt][4 * q4 + 3] * inv_l);
                *(LAS u32x2*)(ost + r32 * AO_STRIDE + (32 * dt + 8 * q4 + 4 * hh) * 2) = o; }
        BAR_LDS();
#pragma unroll
        for (int it = 0; it < 4; ++it) { const int row = (lane >> 3) + 8 * it, part = lane & 7; const size_t hrow = (size_t)b * SEQL + (size_t)c * 64 + 32 * th + row;
            const u32x4 ov = *(LAS const u32x4*)(ost + row * AO_STRIDE + part * 16); const u32x4 gr = garaw[it];
            u32x4 o; o.x = pk2(bflo(ov.x) * silu(bflo(gr.x)), bfhi(ov.x) * silu(bfhi(gr.x))); o.y = pk2(bflo(ov.y) * silu(bflo(gr.y)), bfhi(ov.y) * silu(bfhi(gr.y)));
            o.z = pk2(bflo(ov.z) * silu(bflo(gr.z)), bfhi(ov.z) * silu(bfhi(gr.z))); o.w = pk2(bflo(ov.w) * silu(bflo(gr.w)), bfhi(ov.w) * silu(bfhi(gr.w)));
            *(u32x4*)(MIX + hrow * DM + hq * 64 + part * 8) = o; }
    }
#undef ATT_ISSUE
    __syncthreads();
}
constexpr int GQ_STRIDE = 272, GT_STRIDE = 144, GO_STRIDE = 528;
constexpr int G_QD = 0, G_KD = G_QD + 64 * GQ_STRIDE  , G_KT = G_KD + 64 * GQ_STRIDE  , G_VT = G_KT + 128 * GT_STRIDE  ,
              G_ATT = G_VT + 256 * GT_STRIDE  , G_OST = G_ATT + 64 * GT_STRIDE  , G_SEG = G_OST + 64 * GO_STRIDE  , G_DV = G_SEG + 8 * 128 * 4  ,
              G_LR = G_DV + 512  , G_GN = G_LR + 4096  , G_WG = G_GN + 1024  , G_END = G_WG + 8192;
static_assert(G_END <= LDS_BYTES, "GLA LDS");
struct GlaItem { int sample, grp, bh, b, hd, c_begin, nchunks, T, cid0; size_t row0; };
DI GlaItem gla_item(int item) {
    GlaItem g; g.sample = item >= 256; g.grp = g.sample ? 0 : (item & 7); g.bh = g.sample ? item - 256 : (item >> 3); g.b = g.bh >> 2; g.hd = g.bh & 3;
    g.c_begin = g.sample ? 0 : 8 * g.grp; g.nchunks = g.sample ? 1 : 8; g.T = g.sample ? DECS : 64;
    g.row0 = g.sample ? (size_t)MP + g.b * DECS : (size_t)g.b * SEQL;
    g.cid0 = g.sample ? 2048 + g.bh : (g.b * 64) * 4 + g.hd;
    return g;
}
DI void gla_put_vt(LAS unsigned char* lds, int tid, const u32x4 (&vraw)[2][2]) {
#pragma unroll
    for (int it = 0; it < 2; ++it) { const int unit = tid + NTHREADS * it, tp = unit & 31, dvb = unit >> 5;
        const u32x4 a = vraw[it][0], bq = vraw[it][1];
        LAS unsigned char* vb = lds + G_VT + (8 * dvb) * GT_STRIDE + tp * 4;
        *(LAS unsigned*)(vb + 0 * GT_STRIDE) = (a.x & 0xffffu) | (bq.x << 16); *(LAS unsigned*)(vb + 1 * GT_STRIDE) = (a.x >> 16) | (bq.x & 0xffff0000u);
        *(LAS unsigned*)(vb + 2 * GT_STRIDE) = (a.y & 0xffffu) | (bq.y << 16); *(LAS unsigned*)(vb + 3 * GT_STRIDE) = (a.y >> 16) | (bq.y & 0xffff0000u);
        *(LAS unsigned*)(vb + 4 * GT_STRIDE) = (a.z & 0xffffu) | (bq.z << 16); *(LAS unsigned*)(vb + 5 * GT_STRIDE) = (a.z >> 16) | (bq.z & 0xffff0000u);
        *(LAS unsigned*)(vb + 6 * GT_STRIDE) = (a.w & 0xffffu) | (bq.w << 16); *(LAS unsigned*)(vb + 7 * GT_STRIDE) = (a.w >> 16) | (bq.w & 0xffff0000u); }
}
#define GLA_ISSUE_V(CH) do { const size_t rb_ = g.row0 + (size_t)(CH) * 64; \
        _Pragma("unroll") for (int it_ = 0; it_ < 2; ++it_) { const int un_ = tid + NTHREADS * it_, tp_ = un_ & 31, dvb_ = un_ >> 5; \
            _Pragma("unroll") for (int k_ = 0; k_ < 2; ++k_) { const int t_ = 2 * tp_ + k_; vraw[it_][k_] = (u32x4){0u, 0u, 0u, 0u}; \
                if (t_ < g.T) vraw[it_][k_] = *(const u32x4*)(H + (rb_ + t_) * LDH + C_VG + g.hd * 256 + 8 * dvb_); } } } while (0)
DI void gla_state_update(LAS unsigned char* lds, f32x16 (&S)[4], int w, int r32, int hh) {
    LAS const float* dvec = (LAS const float*)(lds + G_DV);
#pragma unroll
    for (int mt = 0; mt < 4; ++mt) {
#pragma unroll
        for (int q4 = 0; q4 < 4; ++q4) { const f32x4 dv4 = *(LAS const f32x4*)(dvec + 32 * mt + 8 * q4 + 4 * hh);
            S[mt][4 * q4] *= dv4.x; S[mt][4 * q4 + 1] *= dv4.y; S[mt][4 * q4 + 2] *= dv4.z; S[mt][4 * q4 + 3] *= dv4.w; }
#pragma unroll
        for (int s = 0; s < 4; ++s) S[mt] = MFMA32(lds_b128(lds + G_KT + (32 * mt + r32) * GT_STRIDE + (16 * s + 8 * hh) * 2), lds_b128(lds + G_VT + (32 * w + r32) * GT_STRIDE + (16 * s + 8 * hh) * 2), S[mt]); }
}

DI void gla_prep(const Params& P, LAS unsigned char* lds, int tid, int item) {
    asm volatile("" : "+v"(tid));
    bf16* H = (bf16*)(P.ws + WS_H); bf16* KT = (bf16*)(P.ws + WS_KT); float* DVB = (float*)(P.ws + WS_DV);
    float* LBUF = (float*)(P.ws + WS_L); float* DBUF = (float*)(P.ws + WS_D);
    const int lane = tid & 63, w = tid >> 6, r32 = lane & 31, hh = lane >> 5;
    const GlaItem g = gla_item(item);
    const bool need_state = !g.sample && g.grp < 7;
    const int dp = lane, d0 = 2 * dp;
    for (int i = tid; i < 16 * 32; i += NTHREADS) { const int r = i >> 5, c4 = i & 31; *(LAS f32x4*)(lds + G_WG + r * 512 + c4 * 16) = *(const f32x4*)(P.w_gu + (size_t)r * 512 + g.hd * 128 + c4 * 4); }
    const f32x2_t bg = *(const f32x2_t*)(P.b_gate + g.hd * 128 + d0);
    f32x16 S[4];
#pragma unroll
    for (int mt = 0; mt < 4; ++mt) S[mt] = zero16();
    float gt0 = 0.f, gt1 = 0.f;
    LAS float* seg = (LAS float*)(lds + G_SEG); LAS float* dvec = (LAS float*)(lds + G_DV);
    u32x4 lrp = (u32x4){0u, 0u, 0u, 0u}; unsigned qraw[8], kraw[8];
#define GLA_ISSUE(CH) do { const size_t rb_ = g.row0 + (size_t)(CH) * 64; \
        lrp = (u32x4){0u, 0u, 0u, 0u}; if (tid < 128 && (tid >> 1) < g.T) lrp = *(const u32x4*)(H + (rb_ + (tid >> 1)) * LDH + C_LR + (tid & 1) * 8); \
        _Pragma("unroll") for (int i_ = 0; i_ < 8; ++i_) { const int t_ = 8 * w + i_; qraw[i_] = 0u; kraw[i_] = 0u; \
            if (t_ < g.T) { const bf16* hr_ = H + (rb_ + t_) * LDH; qraw[i_] = *(const unsigned*)(hr_ + C_QG + g.hd * 128 + d0); kraw[i_] = *(const unsigned*)(hr_ + C_KG + g.hd * 128 + d0); } } } while (0)
#define GLA_PUT_LR() do { if (tid < 128) { LAS float* d_ = (LAS float*)(lds + G_LR) + (tid >> 1) * 16 + (tid & 1) * 8; \
        *(LAS f32x4*)d_ = (f32x4){bflo(lrp.x), bfhi(lrp.x), bflo(lrp.y), bfhi(lrp.y)}; *(LAS f32x4*)(d_ + 4) = (f32x4){bflo(lrp.z), bfhi(lrp.z), bflo(lrp.w), bfhi(lrp.w)}; } } while (0)
    GLA_ISSUE(g.c_begin);
    GLA_PUT_LR();
    __syncthreads();
    for (int c = g.c_begin; c < g.c_begin + g.nchunks; ++c) {
        const size_t rowb = g.row0 + (size_t)c * 64; const int cid = g.cid0 + 4 * c;
        u32x4 vraw[2][2];
        if (need_state) GLA_ISSUE_V(c);
        float cs0[8], cs1[8];
        float run0 = 0.f, run1 = 0.f;
        { f32x2_t wgv[16];
#pragma unroll
          for (int r = 0; r < 16; ++r) wgv[r] = *(LAS const f32x2_t*)(lds + G_WG + r * 512 + d0 * 4);
#pragma unroll
          for (int i = 0; i < 8; ++i) { const int t = 8 * w + i;
            LAS const f32x4* lp = (LAS const f32x4*)(lds + G_LR + t * 64);
            f32x2_t z = bg;
#pragma unroll
            for (int r4 = 0; r4 < 4; ++r4) { const f32x4 l4 = lp[r4];
                z += wgv[4 * r4] * (f32x2_t){l4.x, l4.x}; z += wgv[4 * r4 + 1] * (f32x2_t){l4.y, l4.y}; z += wgv[4 * r4 + 2] * (f32x2_t){l4.z, l4.z}; z += wgv[4 * r4 + 3] * (f32x2_t){l4.w, l4.w}; }
            float la0 = (fminf(z.x, 0.f) - __logf(1.f + __expf(-fabsf(z.x)))) * (1.f / 16.f);
            float la1 = (fminf(z.y, 0.f) - __logf(1.f + __expf(-fabsf(z.y)))) * (1.f / 16.f);
            if (t >= g.T) { la0 = 0.f; la1 = 0.f; }
            run0 += la0; run1 += la1; cs0[i] = run0; cs1[i] = run1; } }
        *(LAS f32x2_t*)(seg + w * 128 + d0) = (f32x2_t){run0, run1};
        BAR_LDS();
        float pre0 = 0.f, pre1 = 0.f, tot0 = 0.f, tot1 = 0.f;
#pragma unroll
        for (int ww = 0; ww < 8; ++ww) { const f32x2_t sv = *(LAS const f32x2_t*)(seg + ww * 128 + d0); tot0 += sv.x; tot1 += sv.y; if (ww < w) { pre0 += sv.x; pre1 += sv.y; } }
        const float et0 = __expf(tot0), et1 = __expf(tot1);
        if (w == 0) *(LAS f32x2_t*)(dvec + d0) = (f32x2_t){et0, et1};
        gt0 += tot0; gt1 += tot1;
        unsigned ko0[4], ko1[4];
#pragma unroll
        for (int i = 0; i < 8; ++i) { const int t = 8 * w + i;
            const float bc0 = pre0 + cs0[i], bc1 = pre1 + cs1[i];
            const float q0 = bflo(qraw[i]), q1 = bfhi(qraw[i]), k0 = bflo(kraw[i]), k1 = bfhi(kraw[i]);
            const float e0 = __expf(bc0), e1 = __expf(bc1), r0 = __builtin_amdgcn_rcpf(e0), r1 = __builtin_amdgcn_rcpf(e1);
            *(LAS unsigned*)(lds + G_QD + t * GQ_STRIDE + dp * 4) = pk2(q0 * e0 * 0.08838834764831845f, q1 * e1 * 0.08838834764831845f);
            *(LAS unsigned*)(lds + G_KD + t * GQ_STRIDE + dp * 4) = pk2(k0 * r0, k1 * r1);
            const float o0 = k0 * (et0 * r0), o1 = k1 * (et1 * r1);
            if (i & 1) { ko0[i >> 1] = pk2(__uint_as_float(ko0[i >> 1]), o0); ko1[i >> 1] = pk2(__uint_as_float(ko1[i >> 1]), o1); }
            else { ko0[i >> 1] = __float_as_uint(o0); ko1[i >> 1] = __float_as_uint(o1); } }
        *(LAS u32x4*)(lds + G_KT + d0 * GT_STRIDE + w * 16) = (u32x4){ko0[0], ko0[1], ko0[2], ko0[3]};
        *(LAS u32x4*)(lds + G_KT + (d0 + 1) * GT_STRIDE + w * 16) = (u32x4){ko1[0], ko1[1], ko1[2], ko1[3]};
        if (need_state) gla_put_vt(lds, tid, vraw);
        const bool more = c + 1 < g.c_begin + g.nchunks;
        if (more) GLA_ISSUE(c + 1);
        BAR_LDS();
#pragma unroll
        for (int i = 0; i < 2; ++i) { const int p = tid + NTHREADS * i, fr = p >> 4, pc = p & 15;
            if (fr < g.T) { bf16* hr = H + (rowb + fr) * LDH + g.hd * 128 + pc * 8;
                *(u32x4*)(hr + C_QG) = *(LAS const u32x4*)(lds + G_QD + fr * GQ_STRIDE + pc * 16);
                *(u32x4*)(hr + C_KG) = *(LAS const u32x4*)(lds + G_KD + fr * GQ_STRIDE + pc * 16); }
            const int dk = p >> 3, p8 = p & 7;
            *(u32x4*)(KT + ((size_t)cid * 128 + dk) * 64 + p8 * 8) = *(LAS const u32x4*)(lds + G_KT + dk * GT_STRIDE + p8 * 16); }
        if (tid < 32) *(f32x4*)(DVB + (size_t)cid * 128 + tid * 4) = *(LAS const f32x4*)(dvec + tid * 4);
        if (need_state) gla_state_update(lds, S, w, r32, hh);
        if (more) GLA_PUT_LR();
        BAR_LDS();
    }
#undef GLA_ISSUE
#undef GLA_PUT_LR
    if (need_state) {
        float* so = LBUF + ((size_t)item * 128) * 256 + 32 * w + r32;
#pragma unroll
        for (int mt = 0; mt < 4; ++mt)
#pragma unroll
            for (int e = 0; e < 16; ++e) so[(size_t)(32 * mt + 8 * (e >> 2) + 4 * hh + (e & 3)) * 256] = S[mt][e];
        if (w == 0) *(f32x2_t*)(DBUF + (size_t)item * 128 + d0) = (f32x2_t){__expf(gt0), __expf(gt1)};
    }
}

DI void gla_scan(const Params& P, LAS unsigned char* lds, int tid, int item) {
    asm volatile("" : "+v"(tid));
    const bf16* H = (const bf16*)(P.ws + WS_H); bf16* MIX = (bf16*)(P.ws + WS_MIX); const bf16* KT = (const bf16*)(P.ws + WS_KT); const float* DVB = (const float*)(P.ws + WS_DV);
    const float* LBUF = (const float*)(P.ws + WS_L); const float* DBUF = (const float*)(P.ws + WS_D);
    const int lane = tid & 63, w = tid >> 6, r32 = lane & 31, hh = lane >> 5;
    const GlaItem g = gla_item(item);
    if (tid < 64) *(LAS f32x4*)(lds + G_GN + tid * 16) = *(const f32x4*)(P.gng + tid * 4);
    f32x16 S[4];
#pragma unroll
    for (int mt = 0; mt < 4; ++mt) S[mt] = zero16();
    if (g.sample) { const float* sp = P.state + ((size_t)g.bh * 128) * 256 + 32 * w + r32;
#pragma unroll
        for (int mt = 0; mt < 4; ++mt)
#pragma unroll
            for (int e = 0; e < 16; ++e) S[mt][e] = sp[(size_t)(32 * mt + 8 * (e >> 2) + 4 * hh + (e & 3)) * 256]; }
    else {
        for (int gp = 0; gp < g.grp; ++gp) { const float* lp = LBUF + ((size_t)(g.bh * 8 + gp) * 128) * 256 + 32 * w + r32; const float* dpv = DBUF + (size_t)(g.bh * 8 + gp) * 128;
#pragma unroll
            for (int mt = 0; mt < 4; ++mt)
#pragma unroll
                for (int q4 = 0; q4 < 4; ++q4) { const f32x4 d4 = *(const f32x4*)(dpv + 32 * mt + 8 * q4 + 4 * hh);
#pragma unroll
                    for (int e = 0; e < 4; ++e) S[mt][4 * q4 + e] = S[mt][4 * q4 + e] * d4[e] + lp[(size_t)(32 * mt + 8 * q4 + 4 * hh + e) * 256]; } } }
    u32x4 qdr[2], kdr[2], ktr[2], vraw[2][2]; f32x4 dvr = (f32x4){0.f, 0.f, 0.f, 0.f};
#define SCAN_ISSUE(CH) do { const size_t rb_ = g.row0 + (size_t)(CH) * 64; const int cid_ = g.cid0 + 4 * (CH); \
        _Pragma("unroll") for (int i_ = 0; i_ < 2; ++i_) { const int p_ = tid + NTHREADS * i_, fr_ = p_ >> 4, pc_ = p_ & 15; \
            qdr[i_] = (u32x4){0u, 0u, 0u, 0u}; kdr[i_] = (u32x4){0u, 0u, 0u, 0u}; \
            if (fr_ < g.T) { const bf16* hr_ = H + (rb_ + fr_) * LDH + g.hd * 128 + pc_ * 8; qdr[i_] = *(const u32x4*)(hr_ + C_QG); kdr[i_] = *(const u32x4*)(hr_ + C_KG); } \
            ktr[i_] = *(const u32x4*)(KT + ((size_t)cid_ * 128 + (p_ >> 3)) * 64 + (p_ & 7) * 8); } \
        if (tid < 32) dvr = *(const f32x4*)(DVB + (size_t)cid_ * 128 + tid * 4); \
        GLA_ISSUE_V(CH); } while (0)
    SCAN_ISSUE(g.c_begin);
    for (int c = g.c_begin; c < g.c_begin + g.nchunks; ++c) {
        const size_t rowb = g.row0 + (size_t)c * 64;
#pragma unroll
        for (int i = 0; i < 2; ++i) { const int p = tid + NTHREADS * i, fr = p >> 4, pc = p & 15;
            *(LAS u32x4*)(lds + G_QD + fr * GQ_STRIDE + pc * 16) = qdr[i]; *(LAS u32x4*)(lds + G_KD + fr * GQ_STRIDE + pc * 16) = kdr[i];
            *(LAS u32x4*)(lds + G_KT + (p >> 3) * GT_STRIDE + (p & 7) * 16) = ktr[i]; }
        if (tid < 32) *(LAS f32x4*)(lds + G_DV + tid * 16) = dvr;
        gla_put_vt(lds, tid, vraw);
        const bool more = c + 1 < g.c_begin + g.nchunks;
        if (more) SCAN_ISSUE(c + 1);
        BAR_LDS();
        if (w < 3) { const int it = (w >= 1), jt = (w == 2);
            f32x16 a = zero16();
#pragma unroll
            for (int s = 0; s < 8; ++s) a = MFMA32(lds_b128(lds + G_KD + (32 * jt + r32) * GQ_STRIDE + (16 * s + 8 * hh) * 2), lds_b128(lds + G_QD + (32 * it + r32) * GQ_STRIDE + (16 * s + 8 * hh) * 2), a);
            const int i = 32 * it + r32;
#pragma unroll
            for (int q4 = 0; q4 < 4; ++q4) { float v[4];
#pragma unroll
                for (int e = 0; e < 4; ++e) { const int j = 32 * jt + 8 * q4 + 4 * hh + e; v[e] = (j <= i) ? a[4 * q4 + e] : 0.f; }
                *(LAS u32x2*)(lds + G_ATT + i * GT_STRIDE + (32 * jt + 8 * q4 + 4 * hh) * 2) = (u32x2){pk2(v[0], v[1]), pk2(v[2], v[3])}; } }
        else if (w == 3) {
#pragma unroll
            for (int q4 = 0; q4 < 4; ++q4) *(LAS u32x2*)(lds + G_ATT + r32 * GT_STRIDE + (32 + 8 * q4 + 4 * hh) * 2) = (u32x2){0u, 0u}; }
        BAR_LDS();
#pragma unroll
        for (int it = 0; it < 2; ++it) { f32x16 oacc = zero16();
#pragma unroll
          for (int mt = 0; mt < 4; ++mt) {
            const bf16x8 s0 = pack_step<0>(S[mt]), s1 = pack_step<1>(S[mt]);
            LAS const unsigned char* qb = lds + G_QD + (32 * it + r32) * GQ_STRIDE + (32 * mt + 4 * hh) * 2;
            oacc = MFMA32(s0, lds_2xb64(qb, qb + 16), oacc);
            oacc = MFMA32(s1, lds_2xb64(qb + 32, qb + 48), oacc); }
#pragma unroll
          for (int s = 0; s < 4; ++s) oacc = MFMA32(lds_b128(lds + G_VT + (32 * w + r32) * GT_STRIDE + (16 * s + 8 * hh) * 2), lds_b128(lds + G_ATT + (32 * it + r32) * GT_STRIDE + (16 * s + 8 * hh) * 2), oacc);
#pragma unroll
          for (int q4 = 0; q4 < 4; ++q4)
            *(LAS u32x2*)(lds + G_OST + (32 * it + r32) * GO_STRIDE + (32 * w + 8 * q4 + 4 * hh) * 2) = (u32x2){pk2(oacc[4 * q4], oacc[4 * q4 + 1]), pk2(oacc[4 * q4 + 2], oacc[4 * q4 + 3])}; }
        gla_state_update(lds, S, w, r32, hh);
        u32x4 ggraw[4];
        { const int i = tid >> 3, part = tid & 7;
#pragma unroll
          for (int q = 0; q < 4; ++q) { ggraw[q] = (u32x4){0u, 0u, 0u, 0u}; if (i < g.T) ggraw[q] = *(const u32x4*)(H + (rowb + i) * LDH + C_GG + g.hd * 256 + (8 * q + part) * 8); } }
        BAR_LDS();
        { const int i = tid >> 3, part = tid & 7; float ov[4][8]; float ss = 0.f;
#pragma unroll
          for (int q = 0; q < 4; ++q) { const u32x4 rv = *(LAS const u32x4*)(lds + G_OST + i * GO_STRIDE + (8 * q + part) * 16);
              ov[q][0] = bflo(rv.x); ov[q][1] = bfhi(rv.x); ov[q][2] = bflo(rv.y); ov[q][3] = bfhi(rv.y); ov[q][4] = bflo(rv.z); ov[q][5] = bfhi(rv.z); ov[q][6] = bflo(rv.w); ov[q][7] = bfhi(rv.w);
#pragma unroll
              for (int e = 0; e < 8; ++e) ss += ov[q][e] * ov[q][e]; }
          ss += __shfl_xor(ss, 1); ss += __shfl_xor(ss, 2); ss += __shfl_xor(ss, 4);
          const float rs = rsqrtf(ss * (1.f / 256.f) + EPS);
          if (i < g.T) { const size_t hrow = rowb + i;
#pragma unroll
              for (int q = 0; q < 4; ++q) { const int cq = 8 * q + part; const u32x4 gr = ggraw[q];
                  const f32x4 n0 = *(LAS const f32x4*)(lds + G_GN + cq * 32), n1 = *(LAS const f32x4*)(lds + G_GN + cq * 32 + 16);
                  u32x4 o; o.x = pk2(ov[q][0] * rs * n0.x * silu(bflo(gr.x)), ov[q][1] * rs * n0.y * silu(bfhi(gr.x))); o.y = pk2(ov[q][2] * rs * n0.z * silu(bflo(gr.y)), ov[q][3] * rs * n0.w * silu(bfhi(gr.y)));
                  o.z = pk2(ov[q][4] * rs * n1.x * silu(bflo(gr.z)), ov[q][5] * rs * n1.y * silu(bfhi(gr.z))); o.w = pk2(ov[q][6] * rs * n1.z * silu(bflo(gr.w)), ov[q][7] * rs * n1.w * silu(bfhi(gr.w)));
                  *(u32x4*)(MIX + hrow * DM + 1024 + g.hd * 256 + cq * 8) = o; } } }
    }
#undef SCAN_ISSUE
    if (g.sample || g.grp == 7) {
        float* so = P.out + (g.sample ? O_GS : O_GP) + ((size_t)g.bh * 128) * 256 + 32 * w + r32;
#pragma unroll
        for (int mt = 0; mt < 4; ++mt)
#pragma unroll
            for (int e = 0; e < 16; ++e) so[(size_t)(32 * mt + 8 * (e >> 2) + 4 * hh + (e & 3)) * 256] = S[mt][e];
    }
    __syncthreads();
}
#undef GLA_ISSUE_V
__global__ void __launch_bounds__(NTHREADS, 2) hymba_fwd(Params P) {
    extern __shared__ __attribute__((aligned(16))) unsigned char smem[];
    LAS unsigned char* lds = (LAS unsigned char*)smem;
    cg::grid_group grid = cg::this_grid();
    const int tid = threadIdx.x, G = gridDim.x, blk = blockIdx.x;
    bf16* WG = (bf16*)(P.ws + WS_WG); bf16* WO = (bf16*)(P.ws + WS_WO); bf16* XB = (bf16*)(P.ws + WS_XB); bf16* MIX = (bf16*)(P.ws + WS_MIX); bf16* H = (bf16*)(P.ws + WS_H);

    unsigned* barw = (unsigned*)(P.ws + WS_CTL);
    if (blk == 0) for (int i = tid; i < XCD_BAR_WORDS; i += NTHREADS) barw[i] = 0u;
    if (tid < 16) *(LAS unsigned*)(lds + LDS_ST_OFF + tid * 4) = 0u;
    p0_prologue(P, lds, tid);
    grid.sync();
    XcdBarrier xb = xcd_barrier_post(barw, (volatile LAS unsigned*)(lds + LDS_ST_OFF));

    { pg8::Gemm g{XB, WG, MT, LDH, DM}; pg8::StaticOrder S; S.init(MT, LDH, G, blk);
      pg8::EpiH E{H, LDH};
      pg8::gemm_phase<pg8::EpiH, pg8::StaticOrder, true, true>(lds, g, S, E); }
    xcd_barrier(xb);

    win_items(P, tid);
#pragma unroll 1
    for (int it = blk; it < 320; it += G) { gla_prep(P, lds, tid, (it < 256) ? ((it & 31) * 8 + (it >> 5)) : it); __syncthreads(); }
    xcd_barrier(xb);
#pragma unroll 1
    for (int it = blk; it < 320; it += G) gla_scan(P, lds, tid, (it < 256) ? ((it & 31) * 8 + (it >> 5)) : it);
    att_loop(P, lds, tid, blk, G, 2048);
#pragma unroll 1
    for (int u = 2048 + blk; u < 2048 + 64; u += G) { att_unit(P, lds, tid, u); __syncthreads(); }
    xcd_barrier(xb);

    { pg8::Gemm g{MIX, WO, MT, DM, DM}; pg8::StaticOrder S; S.init(MT, DM, G, blk);
      pg8::EpiRes E{P.x_p, P.x_s, P.out, MP / 256};
      pg8::gemm_phase<pg8::EpiRes, pg8::StaticOrder, true, true>(lds, g, S, E); }
}

extern "C" void kernel_launch(void* const* d_in, const int* in_sizes, int n_in, void* d_out, int out_size, void* d_ws, size_t ws_size, hipStream_t stream) {
    static int grid_blocks = 0;
    if (grid_blocks == 0) {
        if (n_in != 14 || (size_t)out_size != O_END || ws_size < WS_END) { fprintf(stderr, "kernel_launch: unexpected shapes: n_in %d out %d ws %zu (need %zu)\n", n_in, out_size, ws_size, (size_t)WS_END); grid_blocks = -1; return; }
        int dev = 0, cus = 0, per_cu = 0;
        hipGetDevice(&dev);
        hipDeviceGetAttribute(&cus, hipDeviceAttributeMultiprocessorCount, dev);
        if (hipFuncSetAttribute((const void*)hymba_fwd, hipFuncAttributeMaxDynamicSharedMemorySize, LDS_BYTES) != hipSuccess) { fprintf(stderr, "kernel_launch: hipFuncSetAttribute failed\n"); grid_blocks = -1; return; }
        if (hipOccupancyMaxActiveBlocksPerMultiprocessor(&per_cu, (const void*)hymba_fwd, NTHREADS, LDS_BYTES) != hipSuccess || per_cu < 1) { fprintf(stderr, "kernel_launch: occupancy query says %d blocks per CU\n", per_cu); per_cu = 1; }
        (void)hipGetLastError();
        grid_blocks = cus;
        fprintf(stderr, "kernel_launch: %d CUs, %d blocks/CU by the occupancy query, grid %d\n", cus, per_cu, grid_blocks);
    }
    if (grid_blocks < 0) return;
    Params p{};
    p.x_p = (const float*)d_in[0]; p.x_s = (const float*)d_in[1]; p.cache_k = (const float*)d_in[2]; p.cache_v = (const float*)d_in[3]; p.state = (const float*)d_in[4];
    p.norm_g = (const float*)d_in[5]; p.w_in = (const float*)d_in[6]; p.w_gu = (const float*)d_in[7]; p.b_gate = (const float*)d_in[8]; p.qng = (const float*)d_in[9];
    p.kng = (const float*)d_in[10]; p.sinks = (const float*)d_in[11]; p.gng = (const float*)d_in[12]; p.w_out = (const float*)d_in[13];
    p.out = (float*)d_out; p.ws = (unsigned char*)d_ws;
    void* args[] = {&p};
    hipError_t e = hipLaunchCooperativeKernel((const void*)hymba_fwd, dim3(grid_blocks), dim3(NTHREADS), args, LDS_BYTES, stream);
    if (e != hipSuccess) fprintf(stderr, "kernel_launch: cooperative launch failed: %s (grid %d)\n", hipGetErrorString(e), grid_blocks);
}
```
